# Optimizing an MI355X kernel written in HIP

```python
import math
import jax, jax.numpy as jnp
from jax import lax
import numpy as np

D_MODEL = 1024
BATCH = 8
SEQ = 4096
DEPTH = 2

HEAD_DIM = 64
D_ATTN = D_MODEL // 2
N_ATTN_HEADS = D_ATTN // HEAD_DIM
D_CONV = D_MODEL // 4
N_CONV_GROUPS = D_CONV // HEAD_DIM
D_LRU = D_MODEL // 4
N_LRU_HEADS = D_LRU // HEAD_DIM
LRU_BLOCK = D_LRU // N_LRU_HEADS
D_MIX = D_ATTN + D_CONV + D_LRU
D_IN_PROJ = 3 * D_ATTN + 3 * D_CONV + 2 * D_LRU
D_FF = 4 * D_MODEL
MOBA_BLOCK = 256
MOBA_TOPK = 3
Q_CHUNK = 32
SHORT_CONV_W = 3
LRU_CONV_W = 4
LRU_C = 8.0
N_MOD = 6
EPS = 1e-6

kernel_name = "hymba_moba_conv_rglru_hybrid"


def rms_norm(x, g):
    xf = x.astype(jnp.float32)
    y = xf * lax.rsqrt(jnp.mean(xf * xf, axis=-1, keepdims=True) + EPS)
    return (y * g.astype(jnp.float32)).astype(x.dtype)


def causal_depthwise_conv(x, w):
    k_w, ch = w.shape
    return lax.conv_general_dilated(
        x, w[:, None, :].astype(x.dtype), window_strides=(1,),
        padding=((k_w - 1, 0),), dimension_numbers=("NWC", "WIO", "NWC"),
        feature_group_count=ch)


def moba_attention(q, k, v):
    B, H, S, hd = q.shape
    nb = -(-S // MOBA_BLOCK)
    pad = nb * MOBA_BLOCK - S
    kp = jnp.pad(k, ((0, 0), (0, 0), (0, pad), (0, 0)))
    vp = jnp.pad(v, ((0, 0), (0, 0), (0, pad), (0, 0)))
    kb = kp.reshape(B, H, nb, MOBA_BLOCK, hd)
    vb = vp.reshape(B, H, nb, MOBA_BLOCK, hd)
    kmean = jnp.mean(kb.astype(jnp.float32), axis=3)
    topk = min(MOBA_TOPK, nb)
    scale = 1.0 / math.sqrt(hd)
    bi = jnp.arange(B)[:, None, None, None]
    hi = jnp.arange(H)[None, :, None, None]
    blk_ids = jnp.arange(nb)

    def chunk(start):
        qc = lax.dynamic_slice_in_dim(q, start, Q_CHUNK, axis=2)
        own = start // MOBA_BLOCK
        qpos = start + jnp.arange(Q_CHUNK)
        gate = jnp.einsum("bhqd,bhnd->bhqn", qc.astype(jnp.float32), kmean)
        gate = jnp.where(blk_ids < own, gate, -jnp.inf)
        _, idx = lax.top_k(gate, topk)
        valid = idx < own
        ksel = kb[bi, hi, idx]
        vsel = vb[bi, hi, idx]
        s_sel = jnp.einsum("bhqd,bhqjkd->bhqjk", qc, ksel).astype(jnp.float32) * scale
        s_sel = jnp.where(valid[..., None], s_sel, -jnp.inf)
        s_sel = s_sel.reshape(B, H, Q_CHUNK, topk * MOBA_BLOCK)
        kown = lax.dynamic_slice_in_dim(kp, own * MOBA_BLOCK, MOBA_BLOCK, axis=2)
        vown = lax.dynamic_slice_in_dim(vp, own * MOBA_BLOCK, MOBA_BLOCK, axis=2)
        s_own = jnp.einsum("bhqd,bhkd->bhqk", qc, kown).astype(jnp.float32) * scale
        kpos = own * MOBA_BLOCK + jnp.arange(MOBA_BLOCK)
        s_own = jnp.where(kpos[None, :] <= qpos[:, None], s_own, -jnp.inf)
        p = jax.nn.softmax(jnp.concatenate([s_sel, s_own], axis=-1), axis=-1)
        p_sel = p[..., :topk * MOBA_BLOCK].reshape(B, H, Q_CHUNK, topk, MOBA_BLOCK).astype(v.dtype)
        p_own = p[..., topk * MOBA_BLOCK:].astype(v.dtype)
        return (jnp.einsum("bhqjk,bhqjkd->bhqd", p_sel, vsel)
                + jnp.einsum("bhqk,bhkd->bhqd", p_own, vown))

    starts = jnp.arange(S // Q_CHUNK) * Q_CHUNK
    o = lax.map(chunk, starts)
    return o.transpose(1, 0, 3, 2, 4).reshape(B, S, H * hd)


def rg_lru(x, w_a, b_a, w_x, b_x, lam):
    B, S, _ = x.shape
    xh = x.reshape(B, S, N_LRU_HEADS, LRU_BLOCK)
    r = jax.nn.sigmoid(jnp.einsum("bshi,hij->bshj", xh, w_a).reshape(B, S, D_LRU) + b_a)
    i = jax.nn.sigmoid(jnp.einsum("bshi,hij->bshj", xh, w_x).reshape(B, S, D_LRU) + b_x)
    log_a = -LRU_C * r.astype(jnp.float32) * jax.nn.softplus(-lam.astype(jnp.float32))
    a = jnp.exp(log_a)
    u = jnp.sqrt(-jnp.expm1(2.0 * log_a)) * (i * x).astype(jnp.float32)

    def combine(left, right):
        a1, b1 = left
        a2, b2 = right
        return a1 * a2, a2 * b1 + b2

    _, h = lax.associative_scan(combine, (a, u), axis=1)
    return h.astype(x.dtype)


def hybrid_layer(x, mod, ln1_g, ln2_g, w_in, q_norm_g, k_norm_g, sc_w,
                 lru_conv_w, lru_conv_b, lru_wa, lru_ba, lru_wx, lru_bx, lru_lambda,
                 mix_norm_g, w_out, w_up, w_down):
    B, S, _ = x.shape
    shift1, scale1, gate1, shift2, scale2, gate2 = jnp.split(mod, N_MOD, axis=-1)

    h = rms_norm(x, ln1_g) * (1.0 + scale1[:, None, :]) + shift1[:, None, :]
    proj = h @ w_in
    q, k, v, sc_b, sc_c, sc_u, lru_x, lru_gate = jnp.split(
        proj,
        [D_ATTN, 2 * D_ATTN, 3 * D_ATTN,
         3 * D_ATTN + D_CONV, 3 * D_ATTN + 2 * D_CONV, 3 * D_ATTN + 3 * D_CONV,
         3 * D_ATTN + 3 * D_CONV + D_LRU], axis=-1)

    def heads(t):
        return t.reshape(B, S, N_ATTN_HEADS, HEAD_DIM).transpose(0, 2, 1, 3)
    qh = rms_norm(heads(q), q_norm_g)
    kh = rms_norm(heads(k), k_norm_g)
    y_attn = moba_attention(qh, kh, heads(v))

    y_conv = sc_b * causal_depthwise_conv(sc_c * sc_u, sc_w)

    xr = causal_depthwise_conv(lru_x, lru_conv_w) + lru_conv_b
    y_lru = rg_lru(xr, lru_wa, lru_ba, lru_wx, lru_bx, lru_lambda) * jax.nn.gelu(lru_gate)

    y = jnp.concatenate([
        rms_norm(y_attn, mix_norm_g[:D_ATTN]),
        rms_norm(y_conv, mix_norm_g[D_ATTN:D_ATTN + D_CONV]),
        rms_norm(y_lru, mix_norm_g[D_ATTN + D_CONV:]),
    ], axis=-1)
    x = x + gate1[:, None, :] * (y @ w_out)

    h2 = rms_norm(x, ln2_g) * (1.0 + scale2[:, None, :]) + shift2[:, None, :]
    ff = jnp.square(jax.nn.relu(h2 @ w_up)) @ w_down
    return x + gate2[:, None, :] * ff


def setup_inputs(seed: int = 0) -> dict:
    key = jax.random.key(seed)
    ks = jax.random.split(key, 24)
    f32 = jnp.float32
    L = DEPTH

    def nrm(k, shape, scale):
        return jax.random.normal(k, shape, f32) * scale

    a_c = jax.random.uniform(ks[20], (L, D_LRU), f32, 0.9, 0.999)
    a0 = a_c ** (1.0 / LRU_C)
    lru_lambda = jnp.log(a0) - jnp.log1p(-a0)
    return {
        "x": nrm(ks[0], (BATCH, SEQ, D_MODEL), 1.0),
        "c": nrm(ks[1], (BATCH, D_MODEL), 1.0),
        "ln1_g": 1.0 + nrm(ks[2], (L, D_MODEL), 0.02),
        "ln2_g": 1.0 + nrm(ks[3], (L, D_MODEL), 0.02),
        "w_ada": nrm(ks[4], (L, D_MODEL, N_MOD * D_MODEL), D_MODEL ** -0.5),
        "b_ada": nrm(ks[5], (L, N_MOD * D_MODEL), 0.01),
        "w_in": nrm(ks[6], (L, D_MODEL, D_IN_PROJ), D_MODEL ** -0.5),
        "q_norm_g": 1.0 + nrm(ks[7], (L, HEAD_DIM), 0.02),
        "k_norm_g": 1.0 + nrm(ks[8], (L, HEAD_DIM), 0.02),
        "sc_w": nrm(ks[9], (L, SHORT_CONV_W, D_CONV), SHORT_CONV_W ** -0.5),
        "lru_conv_w": nrm(ks[10], (L, LRU_CONV_W, D_LRU), LRU_CONV_W ** -0.5),
        "lru_conv_b": nrm(ks[11], (L, D_LRU), 0.01),
        "lru_wa": nrm(ks[12], (L, N_LRU_HEADS, LRU_BLOCK, LRU_BLOCK), LRU_BLOCK ** -0.5),
        "lru_ba": nrm(ks[13], (L, D_LRU), 0.01),
        "lru_wx": nrm(ks[14], (L, N_LRU_HEADS, LRU_BLOCK, LRU_BLOCK), LRU_BLOCK ** -0.5),
        "lru_bx": nrm(ks[15], (L, D_LRU), 0.01),
        "lru_lambda": lru_lambda,
        "mix_norm_g": 1.0 + nrm(ks[16], (L, D_MIX), 0.02),
        "w_out": nrm(ks[17], (L, D_MIX, D_MODEL), D_MIX ** -0.5),
        "w_up": nrm(ks[18], (L, D_MODEL, D_FF), D_MODEL ** -0.5),
        "w_down": nrm(ks[19], (L, D_FF, D_MODEL), D_FF ** -0.5),
    }


def reference(x, c, ln1_g, ln2_g, w_ada, b_ada, w_in, q_norm_g, k_norm_g, sc_w,
              lru_conv_w, lru_conv_b, lru_wa, lru_ba, lru_wx, lru_bx, lru_lambda,
              mix_norm_g, w_out, w_up, w_down):
    c_act = jax.nn.silu(c)
    for l in range(DEPTH):
        mod = c_act @ w_ada[l] + b_ada[l]
        x = hybrid_layer(x, mod, ln1_g[l], ln2_g[l], w_in[l], q_norm_g[l], k_norm_g[l],
                         sc_w[l], lru_conv_w[l], lru_conv_b[l], lru_wa[l], lru_ba[l],
                         lru_wx[l], lru_bx[l], lru_lambda[l], mix_norm_g[l], w_out[l],
                         w_up[l], w_down[l])
    return x
```

```cpp
#include <hip/hip_runtime.h>
#include <hip/hip_cooperative_groups.h>
#include <cstdio>
#include <cstdint>
namespace cg = cooperative_groups;
namespace pg8 {
#define PG8_LAS __attribute__((address_space(3)))
typedef unsigned short bf16_t;
typedef _Float16 bf16x8 __attribute__((ext_vector_type(8)));
typedef float f32x4 __attribute__((ext_vector_type(4)));
typedef unsigned u32x4 __attribute__((ext_vector_type(4)));
constexpr int BM = 256, BK = 64, HALF = 128, HTB = HALF * BK * 2  , STAGE_BYTES = 8 * HTB, NXCD = 8, WGM = 8;

__host__ __device__ __forceinline__ int lds_byte(int r, int c) { const int st = (r >> 4) * 2 + (c >> 5), rr = r & 15, cc = c & 31, ob = rr * 64 + cc * 2; return st * 1024 + (ob ^ (((ob >> 9) & 1) << 5)); }
__host__ __device__ __forceinline__ void stage_rc(int b, int& R, int& C) { const int st = b / 1024, sb = b % 1024, swz = sb ^ (((sb >> 9) & 1) << 5); R = (st >> 1) * 16 + swz / 64; C = (st & 1) * 32 + (swz % 64) / 2; }
__host__ __device__ __forceinline__ int perm32(int rho) { const int n = rho >> 4, i = rho & 15; return 8 * (i >> 2) + 4 * n + (i & 3); }

struct Unit { int pm, pn; };
struct Gemm { const bf16_t* A; const bf16_t* Bt; int M, N, K; };

struct StaticOrder {
    int nM, nN, nwg, G, c;
    __host__ __device__ void init(int M, int N, int G_, int c_) { nM = M / BM; nN = N / BM; nwg = nM * nN; G = G_; c = c_; }
    __host__ __device__ bool next(int i, Unit& u) const {
        const long L = (long)i * G + c; if (L >= nwg) return false;
        int wgid = (int)L; { const int q = nwg / NXCD, r = nwg % NXCD, xcd = wgid % NXCD, off = wgid / NXCD; wgid = (xcd < r ? xcd * (q + 1) : r * (q + 1) + (xcd - r) * q) + off; }
        const int nig = WGM * nN, gid = wgid / nig, fm = gid * WGM, gsz = (nM - fm) < WGM ? (nM - fm) : WGM;
        u.pm = fm + ((wgid % nig) % gsz); u.pn = (wgid % nig) / gsz; return true;
    }
    __device__ __forceinline__ void a_ready(const Unit&) const {}
    __device__ __forceinline__ void done(const Unit&) const {}
};
typedef float f32x2 __attribute__((ext_vector_type(2)));
typedef _Float16 h16x2 __attribute__((ext_vector_type(2)));
__device__ __forceinline__ unsigned pk_h2(float lo, float hi) { f32x2 v = {lo, hi}; h16x2 h = __builtin_convertvector(v, h16x2); return __builtin_bit_cast(unsigned, h); }
template <int ACT  > struct EpiH16 {
    static constexpr bool PERM = true, AFTER_DRAIN = false;
    bf16_t* O; int ldc;
    __device__ __forceinline__ void operator()(const f32x4 (&acc)[2][2][4][2], const Unit& u, int wr, int wc, int fr, int fq) const {
        const int row0 = u.pm * BM + wr * 64 + fr; const int col0 = u.pn * BM + wc * 32 + 8 * fq;
#pragma unroll
        for (int ai = 0; ai < 2; ++ai)
#pragma unroll
            for (int m = 0; m < 4; ++m) { bf16_t* rowp = O + (size_t)(row0 + ai * HALF + m * 16) * ldc + col0;
#pragma unroll
                for (int bj = 0; bj < 2; ++bj) { f32x4 v0 = acc[ai][bj][m][0], v1 = acc[ai][bj][m][1];
                    if (ACT == 1) {
#pragma unroll
                        for (int j = 0; j < 4; ++j) { float a = v0[j] > 0.f ? v0[j] : 0.f; v0[j] = a * a; float b = v1[j] > 0.f ? v1[j] : 0.f; v1[j] = b * b; } }
                    u32x4 w; w.x = pk_h2(v0[0], v0[1]); w.y = pk_h2(v0[2], v0[3]); w.z = pk_h2(v1[0], v1[1]); w.w = pk_h2(v1[2], v1[3]);
                    *(u32x4*)(rowp + bj * HALF) = w; } }
    }
};
struct EpiRes {
    static constexpr bool PERM = false, AFTER_DRAIN = false;
    const float* base; float* out; int ldc; const float* gate; int gstride;
    __device__ __forceinline__ void operator()(const f32x4 (&acc)[2][2][4][2], const Unit& u, int wr, int wc, int fr, int fq) const {
        const int row0 = u.pm * BM + wr * 64 + fr, col0 = u.pn * BM + wc * 32 + 4 * fq;
        const float* gp = gate + (size_t)(u.pm >> 4) * gstride + col0;
        f32x4 gv[2][2];
#pragma unroll
        for (int bj = 0; bj < 2; ++bj)
#pragma unroll
            for (int n = 0; n < 2; ++n) gv[bj][n] = *(const f32x4*)(gp + bj * HALF + n * 16);
#pragma unroll
        for (int ai = 0; ai < 2; ++ai)
#pragma unroll
            for (int m = 0; m < 4; ++m) { const size_t off = (size_t)(row0 + ai * HALF + m * 16) * ldc + col0;
#pragma unroll
                for (int bj = 0; bj < 2; ++bj)
#pragma unroll
                    for (int n = 0; n < 2; ++n) { const f32x4 bs = *(const f32x4*)(base + off + bj * HALF + n * 16);
                        *(f32x4*)(out + off + bj * HALF + n * 16) = bs + gv[bj][n] * acc[ai][bj][m][n]; } }
    }
};

struct EpiRes16 {
    static constexpr bool PERM = true, AFTER_DRAIN = false;
    const void* base; void* out; int ldc; const float* gate; int gstride; int base_f32, out_f32;
    __device__ __forceinline__ void operator()(const f32x4 (&acc)[2][2][4][2], const Unit& u, int wr, int wc, int fr, int fq) const {
        const int row0 = u.pm * BM + wr * 64 + fr, col0 = u.pn * BM + wc * 32 + 8 * fq;
        const float* gp = gate + (size_t)(u.pm >> 4) * gstride + col0;
        f32x4 gv[2][2];
#pragma unroll
        for (int bj = 0; bj < 2; ++bj)
#pragma unroll
            for (int n = 0; n < 2; ++n) gv[bj][n] = *(const f32x4*)(gp + bj * HALF + 4 * n);
#pragma unroll
        for (int ai = 0; ai < 2; ++ai)
#pragma unroll
            for (int m = 0; m < 4; ++m) { const size_t off = (size_t)(row0 + ai * HALF + m * 16) * ldc + col0;
#pragma unroll
                for (int bj = 0; bj < 2; ++bj) {
                    f32x4 b0, b1;
                    if (base_f32) { const float* bp = (const float*)base + off + bj * HALF; b0 = *(const f32x4*)bp; b1 = *(const f32x4*)(bp + 4); }
                    else { const bf16x8 hv = *(const bf16x8*)((const bf16_t*)base + off + bj * HALF);
                        b0 = (f32x4){(float)hv[0], (float)hv[1], (float)hv[2], (float)hv[3]}; b1 = (f32x4){(float)hv[4], (float)hv[5], (float)hv[6], (float)hv[7]}; }
                    const f32x4 y0 = b0 + gv[bj][0] * acc[ai][bj][m][0], y1 = b1 + gv[bj][1] * acc[ai][bj][m][1];
                    if (out_f32) { float* op = (float*)out + off + bj * HALF; *(f32x4*)op = y0; *(f32x4*)(op + 4) = y1; }
                    else { u32x4 w; w.x = pk_h2(y0[0], y0[1]); w.y = pk_h2(y0[2], y0[3]); w.z = pk_h2(y1[0], y1[1]); w.w = pk_h2(y1[2], y1[3]);
                        *(u32x4*)((bf16_t*)out + off + bj * HALF) = w; } } }
    }
};
struct EpiInProj {
    static constexpr bool PERM = true, AFTER_DRAIN = false;
    bf16_t* O; const float* qg; const float* kg; float* kmean; float qscale;
    __device__ __forceinline__ void operator()(const f32x4 (&acc)[2][2][4][2], const Unit& u, int wr, int wc, int fr, int fq) const {
        constexpr int LDC = 2816;
        int fr_ = fr, fq_ = fq; asm volatile("" : "+v"(fr_), "+v"(fq_));
        const int row0 = u.pm * BM + wr * 64 + fr_;
        if (u.pn >= 4) {
            const int col0 = u.pn * BM + wc * 32 + 8 * fq_;
#pragma unroll
            for (int ai = 0; ai < 2; ++ai)
#pragma unroll
                for (int m = 0; m < 4; ++m) { bf16_t* rowp = O + (size_t)(row0 + ai * HALF + m * 16) * LDC + col0;
#pragma unroll
                    for (int bj = 0; bj < 2; ++bj) { const f32x4 v0 = acc[ai][bj][m][0], v1 = acc[ai][bj][m][1];
                        u32x4 w; w.x = pk_h2(v0[0], v0[1]); w.y = pk_h2(v0[2], v0[3]); w.z = pk_h2(v1[0], v1[1]); w.w = pk_h2(v1[2], v1[3]);
                        *(u32x4*)(rowp + bj * HALF) = w; } }
        } else {
            const bool isk = u.pn >= 2;
            const float* gp = (isk ? kg : qg) + 8 * fq_; const float gs = isk ? 1.0f : qscale;
            f32x4 gv[2][2];
#pragma unroll
            for (int bj = 0; bj < 2; ++bj)
#pragma unroll
                for (int n = 0; n < 2; ++n) gv[bj][n] = *(const f32x4*)(gp + 32 * bj + 4 * n) * gs;
            const int col0 = u.pn * BM + wc * 64 + 8 * fq_;
#pragma unroll
            for (int ai = 0; ai < 2; ++ai)
#pragma unroll
                for (int m = 0; m < 4; ++m) {
                    float ss = 0.f;
#pragma unroll
                    for (int bj = 0; bj < 2; ++bj)
#pragma unroll
                        for (int n = 0; n < 2; ++n) { const f32x4 v = acc[ai][bj][m][n]; ss += (v[0] * v[0] + v[1] * v[1]) + (v[2] * v[2] + v[3] * v[3]); }
                    ss += __shfl_xor(ss, 16); ss += __shfl_xor(ss, 32);
                    const float r = rsqrtf(ss * (1.0f / 64.0f) + 1e-6f);
                    bf16_t* rowp = O + (size_t)(row0 + ai * HALF + m * 16) * LDC + col0;
#pragma unroll
                    for (int bj = 0; bj < 2; ++bj) { const f32x4 y0 = acc[ai][bj][m][0] * r * gv[bj][0], y1 = acc[ai][bj][m][1] * r * gv[bj][1];
                        u32x4 w; w.x = pk_h2(y0[0], y0[1]); w.y = pk_h2(y0[2], y0[3]); w.z = pk_h2(y1[0], y1[1]); w.w = pk_h2(y1[2], y1[3]);
                        *(u32x4*)(rowp + 32 * bj) = w; }
                    asm volatile("" ::: "memory"); }
        }
    }
};

template <class Epi, class Sched, bool ALIGN_EPI = false, bool SP2 = false>
__device__ __forceinline__ void gemm_phase(PG8_LAS unsigned char* lds, const Gemm g, const Sched& S, const Epi& E) {
    int tid_ = threadIdx.x; asm volatile("" : "+v"(tid_));
    const int tid = tid_, wid = __builtin_amdgcn_readfirstlane(tid >> 6), lane = tid & 63, wr = wid >> 2, wc = wid & 3, fr = lane & 15, fq = lane >> 4;
    const int K = g.K, nt = K / BK;
    unsigned voffA[2], voffB[2];
#pragma unroll
    for (int i = 0; i < 2; ++i) { int R, C; stage_rc(tid * 16 + i * 8192, R, C); const int Rb = Epi::PERM ? ((R & ~31) + perm32(R & 31)) : R;
        voffA[i] = (unsigned)(R * K + C) * 2u; voffB[i] = (unsigned)(Rb * K + C) * 2u; }
    const size_t kstep = (size_t)(BK * 2);
    const size_t hstep = (size_t)HALF * K * 2;
    const size_t tstep = 2 * hstep;
    const unsigned ldsw = (unsigned)wid * 1024u;
    const int aoff = lds_byte(wr * 64 + fr, fq * 8), boff = lds_byte(wc * 32 + fr, fq * 8);
#define PG8_SA(b, h) (((b) * 2 + (h)) * HTB)
#define PG8_SB(b, h) ((4 + (b) * 2 + (h)) * HTB)
#define PG8_STAGE(bufoff, gbase, voff) do { _Pragma("unroll") for (int _i = 0; _i < 2; ++_i) \
        __builtin_amdgcn_global_load_lds((const unsigned*)((const char*)(gbase) + (voff)[_i]), (PG8_LAS unsigned*)(lds + (bufoff) + ldsw + _i * 8192), 16, 0, 0); } while (0)
#define PG8_LDA(dst, b, h) do { _Pragma("unroll") for (int m = 0; m < 4; ++m) _Pragma("unroll") for (int k = 0; k < 2; ++k) dst[m][k] = *(const PG8_LAS bf16x8*)(lds + PG8_SA(b, h) + aoff + m * 2048 + k * 1024); } while (0)
#define PG8_LDB(dst, b, h) do { _Pragma("unroll") for (int n = 0; n < 2; ++n) _Pragma("unroll") for (int k = 0; k < 2; ++k) dst[n][k] = *(const PG8_LAS bf16x8*)(lds + PG8_SB(b, h) + boff + n * 2048 + k * 1024); } while (0)
#define PG8_MMA(ai, bj, At, Bt) do { __builtin_amdgcn_s_setprio(1); _Pragma("unroll") for (int m = 0; m < 4; ++m) _Pragma("unroll") for (int n = 0; n < 2; ++n) _Pragma("unroll") for (int k = 0; k < 2; ++k) \
        acc[ai][bj][m][n] = __builtin_amdgcn_mfma_f32_16x16x32_f16(Bt[n][k], At[m][k], acc[ai][bj][m][n], 0, 0, 0); __builtin_amdgcn_s_setprio(0); } while (0)
#define PG8_WAIT_V(n) asm volatile("s_waitcnt vmcnt(" #n ")" ::: "memory")
#define PG8_WAIT_L(n) asm volatile("s_waitcnt lgkmcnt(" #n ")" ::: "memory")
#define PG8_BAR __builtin_amdgcn_s_barrier()
#define PG8_SCHED __builtin_amdgcn_sched_barrier(0)
    Unit cur, nxt; int ui = 0;
    if (!S.next(0, cur)) return;
    f32x4 acc[2][2][4][2];
#pragma unroll
    for (int a = 0; a < 2; ++a)
#pragma unroll
        for (int b = 0; b < 2; ++b)
#pragma unroll
            for (int m = 0; m < 4; ++m)
#pragma unroll
                for (int n = 0; n < 2; ++n) acc[a][b][m][n] = (f32x4){0.f, 0.f, 0.f, 0.f};
    bf16x8 At[4][2], B0[2][2], B1[2][2];
    const char* cA = (const char*)g.A + (size_t)cur.pm * tstep; const char* cB = (const char*)g.Bt + (size_t)cur.pn * tstep;
    S.a_ready(cur);
    if constexpr (SP2) {
        PG8_STAGE(PG8_SB(0, 0), cB, voffB); PG8_STAGE(PG8_SB(0, 1), cB + hstep, voffB); PG8_STAGE(PG8_SA(0, 0), cA, voffA); PG8_STAGE(PG8_SA(0, 1), cA + hstep, voffA);
        if (wr == 1) PG8_BAR;
        PG8_WAIT_V(2); PG8_BAR;
        PG8_STAGE(PG8_SB(1, 0), cB + kstep, voffB); PG8_STAGE(PG8_SA(1, 0), cA + kstep, voffA); PG8_STAGE(PG8_SB(1, 1), cB + hstep + kstep, voffB);
        PG8_WAIT_V(6); PG8_BAR;
    } else {
        PG8_STAGE(PG8_SB(0, 0), cB, voffB); PG8_STAGE(PG8_SA(0, 0), cA, voffA); PG8_STAGE(PG8_SB(0, 1), cB + hstep, voffB); PG8_STAGE(PG8_SA(0, 1), cA + hstep, voffA);
        if (wr == 1) PG8_BAR;
        PG8_WAIT_V(4); PG8_BAR;
        PG8_STAGE(PG8_SB(1, 0), cB + kstep, voffB); PG8_STAGE(PG8_SA(1, 0), cA + kstep, voffA); PG8_STAGE(PG8_SB(1, 1), cB + hstep + kstep, voffB);
        PG8_WAIT_V(6); PG8_BAR;
    }
    for (;;) {
        const bool has_next = S.next(ui + 1, nxt);
        const char* nA = has_next ? (const char*)g.A + (size_t)nxt.pm * tstep : cA; const char* nB = has_next ? (const char*)g.Bt + (size_t)nxt.pn * tstep : cB;
        for (int t = 0; t < nt; t += 2) {
            const bool last = (t == nt - 2);
            const char* a1 = cA + (size_t)(t + 1) * kstep;
            const char* a2 = last ? nA : cA + (size_t)(t + 2) * kstep; const char* b2 = last ? nB : cB + (size_t)(t + 2) * kstep;
            const char* a3 = a2 + kstep; const char* b3 = b2 + kstep;
            if (last && has_next) S.a_ready(nxt);
            if constexpr (SP2) {
            PG8_LDB(B0, 0, 0); PG8_LDB(B1, 0, 1); PG8_SCHED; PG8_LDA(At, 0, 0); PG8_STAGE(PG8_SA(1, 1), a1 + hstep, voffA);
            PG8_WAIT_V(8); PG8_WAIT_L(0); PG8_BAR; PG8_MMA(0, 0, At, B0); PG8_MMA(0, 1, At, B1); PG8_BAR; PG8_SCHED;
            PG8_LDA(At, 0, 1); PG8_STAGE(PG8_SB(0, 0), b2, voffB); PG8_STAGE(PG8_SB(0, 1), b2 + hstep, voffB); PG8_STAGE(PG8_SA(0, 0), a2, voffA);
            PG8_WAIT_V(8); PG8_WAIT_L(0); PG8_BAR; PG8_MMA(1, 0, At, B0); PG8_MMA(1, 1, At, B1); PG8_BAR; PG8_SCHED;
            PG8_LDB(B0, 1, 0); PG8_LDB(B1, 1, 1); PG8_SCHED; PG8_LDA(At, 1, 0); PG8_STAGE(PG8_SA(0, 1), a2 + hstep, voffA);
            PG8_WAIT_V(8); PG8_WAIT_L(0); PG8_BAR; PG8_MMA(0, 0, At, B0); PG8_MMA(0, 1, At, B1); PG8_BAR; PG8_SCHED;
            PG8_LDA(At, 1, 1); PG8_STAGE(PG8_SB(1, 0), b3, voffB); PG8_STAGE(PG8_SB(1, 1), b3 + hstep, voffB); PG8_STAGE(PG8_SA(1, 0), a3, voffA);
            PG8_WAIT_V(8); PG8_WAIT_L(0); PG8_BAR; PG8_MMA(1, 0, At, B0); PG8_MMA(1, 1, At, B1); PG8_BAR; PG8_SCHED;
            } else {
            PG8_LDB(B0, 0, 0); PG8_SCHED; PG8_LDA(At, 0, 0); PG8_STAGE(PG8_SA(1, 1), a1 + hstep, voffA);
            PG8_WAIT_L(8); PG8_BAR; PG8_WAIT_L(0); PG8_MMA(0, 0, At, B0); PG8_BAR; PG8_SCHED;
            PG8_LDB(B1, 0, 1); PG8_STAGE(PG8_SB(0, 0), b2, voffB);
            PG8_BAR; PG8_WAIT_L(0); PG8_MMA(0, 1, At, B1); PG8_BAR;
            PG8_LDA(At, 0, 1); PG8_STAGE(PG8_SA(0, 0), a2, voffA);
            PG8_BAR; PG8_WAIT_L(0); PG8_MMA(1, 0, At, B0); PG8_BAR; PG8_SCHED;
            PG8_STAGE(PG8_SB(0, 1), b2 + hstep, voffB);
            PG8_WAIT_V(6); PG8_BAR; PG8_MMA(1, 1, At, B1); PG8_BAR;
            PG8_LDB(B0, 1, 0); PG8_SCHED; PG8_LDA(At, 1, 0); PG8_STAGE(PG8_SA(0, 1), a2 + hstep, voffA);
            PG8_WAIT_L(8); PG8_BAR; PG8_WAIT_L(0); PG8_MMA(0, 0, At, B0); PG8_BAR; PG8_SCHED;
            PG8_LDB(B1, 1, 1); PG8_STAGE(PG8_SB(1, 0), b3, voffB);
            PG8_BAR; PG8_WAIT_L(0); PG8_MMA(0, 1, At, B1); PG8_BAR;
            PG8_LDA(At, 1, 1); PG8_STAGE(PG8_SA(1, 0), a3, voffA);
            PG8_BAR; PG8_WAIT_L(0); PG8_MMA(1, 0, At, B0); PG8_BAR; PG8_SCHED;
            PG8_STAGE(PG8_SB(1, 1), b3 + hstep, voffB);
            PG8_WAIT_V(6); PG8_BAR; PG8_MMA(1, 1, At, B1); PG8_BAR;
            }
        }
        if constexpr (ALIGN_EPI) { if (wr == 0) PG8_BAR; }
        if constexpr (!Epi::AFTER_DRAIN) { E(acc, cur, wr, wc, fr, fq); S.done(cur); }
        if (!has_next) break;
#pragma unroll
        for (int a = 0; a < 2; ++a)
#pragma unroll
            for (int b = 0; b < 2; ++b)
#pragma unroll
                for (int m = 0; m < 4; ++m)
#pragma unroll
                    for (int n = 0; n < 2; ++n) acc[a][b][m][n] = (f32x4){0.f, 0.f, 0.f, 0.f};
        cur = nxt; cA = nA; cB = nB; ++ui;
        if constexpr (ALIGN_EPI) { if (wr == 1) PG8_BAR; }
    }
    PG8_WAIT_V(0);
    if constexpr (!ALIGN_EPI) { if (wr == 0) PG8_BAR; }
    PG8_BAR;
    if constexpr (Epi::AFTER_DRAIN) { E.fused(acc, cur, wr, wc, fr, fq, lds, wid, lane); S.done(cur); }
#undef PG8_SA
#undef PG8_SB
#undef PG8_STAGE
#undef PG8_LDA
#undef PG8_LDB
#undef PG8_MMA
#undef PG8_WAIT_V
#undef PG8_WAIT_L
#undef PG8_BAR
#undef PG8_SCHED
}
}
#define LAS __attribute__((address_space(3)))
#define GAS __attribute__((address_space(1)))
typedef _Float16 h16;
typedef _Float16 h16x8 __attribute__((ext_vector_type(8)));
typedef _Float16 h16x4 __attribute__((ext_vector_type(4)));
typedef _Float16 h16x2v __attribute__((ext_vector_type(2)));
typedef float f32x2 __attribute__((ext_vector_type(2)));
typedef float f32x4 __attribute__((ext_vector_type(4)));
typedef float f32x16 __attribute__((ext_vector_type(16)));
typedef unsigned u32x4 __attribute__((ext_vector_type(4)));
typedef unsigned u32x2 __attribute__((ext_vector_type(2)));
constexpr int B_ = 8, S_ = 4096, D_ = 1024, M_ = B_ * S_, NPROJ = 2816, FF_ = 4096, NL_ = 2;
constexpr int C_Q = 0, C_K = 512, C_V = 1024, C_SCB = 1536, C_SCC = 1792, C_SCU = 2048, C_LX = 2304, C_LG = 2560;
constexpr float EPS_ = 1e-6f, QSCALE = 0.125f * 1.4426950408889634f;
constexpr size_t MiB = 1u << 20;
constexpr size_t OFF_MOD = 0, OFF_KMEAN = 384 * 1024, OFF_PB = 640 * 1024, OFF_AGG = 1 * MiB, OFF_CARRY = 3 * MiB, OFF_W = 4 * MiB;
constexpr int PB_LN1G = 0, PB_LN2G = 1024, PB_QG = 2048, PB_KG = 2112, PB_SCW = 2176, PB_LCW = 2944, PB_LCB = 3968, PB_LWA = 4224, PB_LBA = 20608,
              PB_LWX = 20864, PB_LBX = 37248, PB_LAM = 37504, PB_MIXG = 37760, PB_LAYER = 38784;
static_assert(OFF_PB + 2 * PB_LAYER * 4 <= OFF_AGG, "pb map");
constexpr size_t W_IN = 0, W_OUT = 5767168, W_UP = 7864320, W_DOWN = 16252928, W_LAYER = 24641536;
constexpr size_t OFF_XA = 52 * MiB, OFF_H = 180 * MiB, OFF_YATT = OFF_H, OFF_PCUM = OFF_H + 32 * MiB, OFF_HLOC = OFF_H + 48 * MiB;
constexpr size_t OFF_BIG = 244 * MiB, OFF_PROJ = OFF_BIG, OFF_Y = OFF_BIG + 176 * MiB, OFF_VT = OFF_Y, OFF_HID = OFF_BIG, WS_END = 500 * MiB;
constexpr size_t OFF_WF = 51 * MiB, OFF_SP = 51 * MiB + 256 * 1024;
constexpr int LDS_BYTES = 147456, LDS_BARST = 147456 - 64;
constexpr size_t OFF_BAR = 960 * 1024, BAR_BYTES = 16384;
static_assert(OFF_W + 2 * W_LAYER <= OFF_XA, "ws map");

struct Args { const float* in[21]; float* out; unsigned char* ws; };
enum { I_X = 0, I_C, I_LN1G, I_LN2G, I_WADA, I_BADA, I_WIN, I_QG, I_KG, I_SCW, I_LCW, I_LCB, I_LWA, I_LBA, I_LWX, I_LBX, I_LAM, I_MIXG, I_WOUT, I_WUP, I_WDOWN };

#define LDS_WAIT() asm volatile("s_waitcnt lgkmcnt(0)" ::: "memory")
#define WG_BAR() do { asm volatile("s_waitcnt lgkmcnt(0)" ::: "memory"); __builtin_amdgcn_s_barrier(); asm volatile("" ::: "memory"); } while (0)
__device__ __forceinline__ float wave_sum(float v) {
#pragma unroll
    for (int o = 1; o < 64; o <<= 1) v += __shfl_xor(v, o);
    return v;
}
__device__ __forceinline__ unsigned pkh(float lo, float hi) { f32x2 v = {lo, hi}; h16x2v h = __builtin_convertvector(v, h16x2v); return __builtin_bit_cast(unsigned, h); }
__device__ __forceinline__ float sigmoidf_(float x) { return 1.0f / (1.0f + __expf(-x)); }

__device__ __forceinline__ void transpose_item(const bool HEADPERM, const float* W, int K, int N, h16* WT, LAS float* scr, int item, int lane) {
    const int nblk = N / 32, kb = item / nblk, nb = item % nblk, k0 = 64 * kb, n0 = 32 * nb;
#pragma unroll 8
    for (int i = 0; i < 32; ++i) { const int kk = 2 * i + (lane >> 5); scr[kk * 33 + (lane & 31)] = W[(size_t)(k0 + kk) * N + n0 + (lane & 31)]; }
    LDS_WAIT();
    const int c = lane & 7;
#pragma unroll
    for (int j = 0; j < 4; ++j) { const int n = (lane >> 3) + 8 * j; const LAS float* s = scr + (8 * c) * 33 + n;
        u32x4 o; o.x = pkh(s[0 * 33], s[1 * 33]); o.y = pkh(s[2 * 33], s[3 * 33]); o.z = pkh(s[4 * 33], s[5 * 33]); o.w = pkh(s[6 * 33], s[7 * 33]);
        int nr = n0 + n;
        if (HEADPERM && nr < 1024) { const int a = nr & 255; nr = (nr & ~255) + 128 * ((a >> 5) & 1) + 32 * (a >> 6) + (a & 31); }
        *(u32x4*)(WT + (size_t)nr * K + k0 + 8 * c) = o; }
    LDS_WAIT();
}
__device__ __forceinline__ void p0_phase(const Args& a, LAS unsigned char* lds, int tid, int lane, int wave) {
    unsigned char* ws = a.ws;
    LAS float* CA = (LAS float*)(lds + 69632);
    LAS float* RED = (LAS float*)(lds + 102400);
    for (int i = tid; i < B_ * D_; i += 512) { const float cv = a.in[I_C][i]; CA[i] = cv / (1.0f + __expf(-cv)); }
    __syncthreads();
    float* MOD = (float*)(ws + OFF_MOD);
    for (int it = blockIdx.x; it < 2 * 96; it += gridDim.x) {
        const int l = it / 96, cgp = it % 96, n = cgp * 64 + lane;
        const float* wp = a.in[I_WADA] + ((size_t)l * D_ + wave * 128) * 6144 + n;
        float acc[8];
#pragma unroll
        for (int b = 0; b < 8; ++b) acc[b] = 0.f;
#pragma unroll 8
        for (int kk = 0; kk < 128; ++kk) { const float wv = wp[(size_t)kk * 6144]; const int k = wave * 128 + kk;
#pragma unroll
            for (int b = 0; b < 8; ++b) acc[b] += CA[b * 1024 + k] * wv; }
#pragma unroll
        for (int b = 0; b < 8; ++b) RED[(wave * 8 + b) * 64 + lane] = acc[b];
        __syncthreads();
        { const int b = wave; float s = 0.f;
#pragma unroll
          for (int w2 = 0; w2 < 8; ++w2) s += RED[(w2 * 8 + b) * 64 + lane];
          MOD[((size_t)l * 8 + b) * 6144 + n] = s + a.in[I_BADA][l * 6144 + n]; }
        __syncthreads();
    }
    { float* PB = (float*)(ws + OFF_PB); const int gt = blockIdx.x * 512 + tid, NT = gridDim.x * 512;
#define CP(idx, off, len) for (int i = gt; i < 2 * (len); i += NT) { const int l = i / (len), r = i % (len); PB[l * PB_LAYER + (off) + r] = a.in[idx][i]; }
      CP(I_LN1G, PB_LN1G, 1024) CP(I_LN2G, PB_LN2G, 1024) CP(I_QG, PB_QG, 64) CP(I_KG, PB_KG, 64) CP(I_SCW, PB_SCW, 768) CP(I_LCW, PB_LCW, 1024) CP(I_LCB, PB_LCB, 256)
      CP(I_LWA, PB_LWA, 16384) CP(I_LBA, PB_LBA, 256) CP(I_LWX, PB_LWX, 16384) CP(I_LBX, PB_LBX, 256) CP(I_LAM, PB_LAM, 256) CP(I_MIXG, PB_MIXG, 1024)
#undef CP
    }
    { h16* WF = (h16*)(ws + OFF_WF); float* SP = (float*)(ws + OFF_SP); const int gt = blockIdx.x * 512 + tid, NT = gridDim.x * 512;
      for (int i = gt; i < 65536; i += NT) { const int e = i & 7, ln = (i >> 3) & 63, ks = (i >> 9) & 1, gate = (i >> 10) & 1, jt = (i >> 11) & 3, hh = (i >> 13) & 3, l = i >> 15;
          const int ii = 32 * ks + 8 * (ln >> 4) + e, jj = 16 * jt + (ln & 15);
          WF[i] = (h16)a.in[gate ? I_LWX : I_LWA][((size_t)(l * 4 + hh) * 64 + ii) * 64 + jj]; }
      for (int i = gt; i < 512; i += NT) SP[i] = log1pf(__expf(-a.in[I_LAM][i])); }
    LAS float* scr = (LAS float*)(lds + wave * 8448);
    const int gw = blockIdx.x * 8 + wave, NGW = gridDim.x * 8;
    constexpr int I_A = 16 * 88, I_B = 16 * 32, I_C2 = 16 * 128, I_D = 64 * 32, I_L = I_A + I_B + I_C2 + I_D;
    for (int it = gw; it < 2 * I_L; it += NGW) {
        const int l = it / I_L; int r = it % I_L;
        unsigned char* wl = ws + OFF_W + (size_t)l * W_LAYER;
        const float* src; int Kt, Nt; size_t dof; bool hp = false;
        if (r < I_A) { src = a.in[I_WIN] + (size_t)l * D_ * NPROJ; Kt = D_; Nt = NPROJ; dof = W_IN; hp = true; }
        else if ((r -= I_A) < I_B) { src = a.in[I_WOUT] + (size_t)l * D_ * D_; Kt = D_; Nt = D_; dof = W_OUT; }
        else if ((r -= I_B) < I_C2) { src = a.in[I_WUP] + (size_t)l * D_ * FF_; Kt = D_; Nt = FF_; dof = W_UP; }
        else { r -= I_C2; src = a.in[I_WDOWN] + (size_t)l * FF_ * D_; Kt = FF_; Nt = D_; dof = W_DOWN; }
        transpose_item(hp, src, Kt, Nt, (h16*)(wl + dof), scr, r, lane);
    }
}

__device__ __forceinline__ void ln_phase(const bool XH16, const void* xv_, const float* g, const float* modl, int shift_chunk, int scale_chunk, h16* H, int gw, int NGW, int lane) {
    for (int row0 = gw * 4; row0 < M_; row0 += NGW * 4) {
        const int b = row0 >> 12;
        const float* mb = modl + (size_t)b * 6144;
        f32x4 v[4][4]; float ss[4];
#pragma unroll
        for (int r = 0; r < 4; ++r) {
            if (XH16) { const h16x4* xr = (const h16x4*)((const h16*)xv_ + (size_t)(row0 + r) * D_) + lane;
#pragma unroll
                for (int j = 0; j < 4; ++j) { const h16x4 hv = xr[64 * j];
                    v[r][j] = (f32x4){(float)hv[0], (float)hv[1], (float)hv[2], (float)hv[3]}; } }
            else { const f32x4* xr = (const f32x4*)((const float*)xv_ + (size_t)(row0 + r) * D_) + lane;
#pragma unroll
                for (int j = 0; j < 4; ++j) v[r][j] = xr[64 * j]; } }
        f32x4 cs[4], sh[4];
#pragma unroll
        for (int j = 0; j < 4; ++j) { const int col = 256 * j + 4 * lane;
            cs[j] = *(const f32x4*)(g + col) * (*(const f32x4*)(mb + scale_chunk * 1024 + col) + 1.0f); sh[j] = *(const f32x4*)(mb + shift_chunk * 1024 + col); }
#pragma unroll
        for (int r = 0; r < 4; ++r) { float s = 0.f;
#pragma unroll
            for (int j = 0; j < 4; ++j) s += (v[r][j].x * v[r][j].x + v[r][j].y * v[r][j].y) + (v[r][j].z * v[r][j].z + v[r][j].w * v[r][j].w);
            ss[r] = s; }
#pragma unroll
        for (int o = 1; o < 64; o <<= 1) {
#pragma unroll
            for (int r = 0; r < 4; ++r) ss[r] += __shfl_xor(ss[r], o); }
#pragma unroll
        for (int r = 0; r < 4; ++r) { const float rr = rsqrtf(ss[r] * (1.0f / D_) + EPS_);
#pragma unroll
            for (int j = 0; j < 4; ++j) { const int col = 256 * j + 4 * lane; const f32x4 y = v[r][j] * rr * cs[j] + sh[j];
                u32x2 o; o.x = pkh(y.x, y.y); o.y = pkh(y.z, y.w);
                *(u32x2*)(H + (size_t)(row0 + r) * D_ + col) = o; } }
    }
}

__device__ __forceinline__ void lru_phase(unsigned char* ws, int l, LAS unsigned char* lds, int lane, int wave) {
    const float* PB = (const float*)(ws + OFF_PB) + (size_t)l * PB_LAYER;
    const h16* WF = (const h16*)(ws + OFF_WF) + (size_t)l * 32768; const float* SP = (const float*)(ws + OFF_SP) + l * 256;
    const h16* PROJ = (const h16*)(ws + OFF_PROJ);
    h16* HLOC = (h16*)(ws + OFF_HLOC); h16* PCUM = (h16*)(ws + OFF_PCUM); float* AGG = (float*)(ws + OFF_AGG);
    LAS h16* XH = (LAS h16*)(lds + wave * 17408);
    LAS float* XF = (LAS float*)(lds + wave * 17408 + 4608);
    LAS h16* OP = (LAS h16*)(lds + wave * 17408 + 12800);
    { float* KMEAN = (float*)(ws + OFF_KMEAN); const int c8 = lane & 7, r8 = lane >> 3;
      for (int wi = blockIdx.x * 8 + wave; wi < B_ * 8 * 16; wi += gridDim.x * 8) {
          const int b = wi >> 7, n = (wi >> 3) & 15, h = wi & 7;
          const h16* base = PROJ + ((size_t)b * S_ + n * 256 + r8) * NPROJ + C_K + h * 64 + 8 * c8;
          float ks[8];
#pragma unroll
          for (int j = 0; j < 8; ++j) ks[j] = 0.f;
#pragma unroll 8
          for (int i = 0; i < 32; ++i) { const h16x8 v = *(const h16x8*)(base + (size_t)(8 * i) * NPROJ);
#pragma unroll
              for (int j = 0; j < 8; ++j) ks[j] += (float)v[j]; }
#pragma unroll
          for (int j = 0; j < 8; ++j) { float s = ks[j]; s += __shfl_xor(s, 8); s += __shfl_xor(s, 16); s += __shfl_xor(s, 32); ks[j] = s * (1.0f / 256.0f); }
          if (lane < 8) { float* kp = KMEAN + ((size_t)(b * 8 + h) * 16 + n) * 64 + 8 * lane; *(f32x4*)kp = (f32x4){ks[0], ks[1], ks[2], ks[3]}; *(f32x4*)(kp + 4) = (f32x4){ks[4], ks[5], ks[6], ks[7]}; } } }
    const int j16 = lane & 15, q4 = lane >> 4;
    for (int wi = blockIdx.x * 8 + wave; wi < B_ * 128 * 4; wi += gridDim.x * 8) {
        const int b = wi >> 9, chn = (wi >> 2) & 127, hh = wi & 3, t0 = chn * 32;
        { const int cj = hh * 64 + lane;
          const float* cwp = PB + PB_LCW + cj;
          const float cw0 = cwp[0], cw1 = cwp[256], cw2 = cwp[512], cw3 = cwp[768], cb = PB[PB_LCB + cj];
          const h16* lx = PROJ + ((size_t)b * S_ + t0) * NPROJ + C_LX + cj;
          h16 xin[35];
#pragma unroll
          for (int t = 0; t < 3; ++t) xin[t] = (t0 > 0) ? lx[(t - 3) * NPROJ] : (h16)0.f;
#pragma unroll
          for (int t = 0; t < 32; ++t) xin[3 + t] = lx[(size_t)t * NPROJ];
#pragma unroll
          for (int t = 0; t < 32; ++t) { const float xr = cw0 * (float)xin[t] + cw1 * (float)xin[t + 1] + cw2 * (float)xin[t + 2] + cw3 * (float)xin[t + 3] + cb;
              XF[t * 64 + lane] = xr; XH[t * 72 + lane] = (h16)xr; } }
        LDS_WAIT();
        h16x8 afr[2][2];
#pragma unroll
        for (int tt = 0; tt < 2; ++tt)
#pragma unroll
            for (int ks = 0; ks < 2; ++ks) afr[tt][ks] = *(const LAS h16x8*)(XH + (16 * tt + j16) * 72 + 32 * ks + 8 * q4);
        LDS_WAIT();
        const size_t tokb = (size_t)b * S_ + t0;
#pragma unroll 1
        for (int jt = 0; jt < 4; ++jt) {
            const int j = 16 * jt + j16, cj = hh * 64 + j;
            const h16* wfp = WF + (size_t)((hh * 4 + jt) * 4) * 512 + lane * 8;
            const h16x8 wfa0 = *(const h16x8*)(wfp), wfa1 = *(const h16x8*)(wfp + 512), wfx0 = *(const h16x8*)(wfp + 1024), wfx1 = *(const h16x8*)(wfp + 1536);
            f32x4 pa[2], px[2];
#pragma unroll
            for (int tt = 0; tt < 2; ++tt) { pa[tt] = (f32x4){0.f, 0.f, 0.f, 0.f}; px[tt] = (f32x4){0.f, 0.f, 0.f, 0.f};
                pa[tt] = __builtin_amdgcn_mfma_f32_16x16x32_f16(afr[tt][0], wfa0, pa[tt], 0, 0, 0); pa[tt] = __builtin_amdgcn_mfma_f32_16x16x32_f16(afr[tt][1], wfa1, pa[tt], 0, 0, 0);
                px[tt] = __builtin_amdgcn_mfma_f32_16x16x32_f16(afr[tt][0], wfx0, px[tt], 0, 0, 0); px[tt] = __builtin_amdgcn_mfma_f32_16x16x32_f16(afr[tt][1], wfx1, px[tt], 0, 0, 0); }
            const float ba = PB[PB_LBA + cj], bx = PB[PB_LBX + cj], sp = SP[cj];
            float cA = 1.f, cH = 0.f;
#pragma unroll
            for (int tt = 0; tt < 2; ++tt) {
                float av[4], hv[4]; float hr = 0.f, pr_ = 1.f;
#pragma unroll
                for (int r = 0; r < 4; ++r) { const int t = 16 * tt + 4 * q4 + r; const float xv = XF[t * 64 + j];
                    const float rg = __builtin_amdgcn_rcpf(1.0f + __expf(-(pa[tt][r] + ba))), ig = __builtin_amdgcn_rcpf(1.0f + __expf(-(px[tt][r] + bx)));
                    const float la = -8.0f * rg * sp, aa = __expf(la);
                    const float u = sqrtf(fmaxf(1.0f - aa * aa, 0.f)) * (ig * xv);
                    hr = aa * hr + u; pr_ *= aa; hv[r] = hr; av[r] = pr_; }
                float Ai = pr_, Hi = hr;
                { const float Ap = __shfl_up(Ai, 16), Hp = __shfl_up(Hi, 16); if (q4 >= 1) { Hi = Ai * Hp + Hi; Ai = Ai * Ap; } }
                { const float Ap = __shfl_up(Ai, 32), Hp = __shfl_up(Hi, 32); if (q4 >= 2) { Hi = Ai * Hp + Hi; Ai = Ai * Ap; } }
                float Ae = __shfl_up(Ai, 16), He = __shfl_up(Hi, 16); if (q4 == 0) { Ae = 1.f; He = 0.f; }
                const float Hin = Ae * cH + He, Ain = Ae * cA;
#pragma unroll
                for (int r = 0; r < 4; ++r) { const int t = 16 * tt + 4 * q4 + r; XH[t * 72 + j] = (h16)(hv[r] + av[r] * Hin); OP[t * 72 + j] = (h16)(av[r] * Ain); }
                const float At = __shfl(Ai, 48 + j16), Ht = __shfl(Hi, 48 + j16);
                cH = At * cH + Ht; cA = At * cA;
            }
            if (q4 == 0) { float* ag = AGG + (((size_t)b * 128 + chn) * 256 + cj) * 2; *(f32x2*)ag = (f32x2){cA, cH}; }
        }
        LDS_WAIT();
#pragma unroll
        for (int k = 0; k < 4; ++k) { const int id2 = k * 64 + lane, t = id2 >> 3, c8 = id2 & 7; const size_t o = (tokb + t) * 256 + hh * 64 + 8 * c8;
            *(u32x4*)(HLOC + o) = *(const LAS u32x4*)(XH + t * 72 + 8 * c8); *(u32x4*)(PCUM + o) = *(const LAS u32x4*)(OP + t * 72 + 8 * c8); }
        LDS_WAIT();
    }
}

typedef short s16x4v __attribute__((ext_vector_type(4)));
__device__ __forceinline__ h16x4 vtr4(const LAS h16* p) { return __builtin_bit_cast(h16x4, __builtin_amdgcn_ds_read_tr16_b64_v4i16((LAS s16x4v*)p)); }
constexpr int AT_KP = 72, AT_VP = 96;
constexpr int AT_KB = 128 * AT_KP, AT_VB = 128 * AT_VP;
template <bool OWN>
__device__ __forceinline__ void attn_tile(const LAS h16* Kt0, const LAS h16* Vt0, const h16x8 (&qf)[4], f32x16& o0, f32x16& o1, float& m_run, float& l_run,
                                          bool lsel, int kt, int w, int r32, int hi, int sig, int vbase) {
    f32x16 sa[2][2];
    if (!OWN) {
#pragma unroll
        for (int st = 0; st < 2; ++st) {
            const LAS h16* Kt = Kt0 + 64 * st * AT_KP;
            h16x8 kf[2][4];
#pragma unroll
            for (int sh = 0; sh < 2; ++sh)
#pragma unroll
                for (int ks = 0; ks < 4; ++ks) kf[sh][ks] = *(const LAS h16x8*)(Kt + (32 * sh + sig) * AT_KP + 16 * ks + 8 * hi);
#pragma unroll
            for (int i = 0; i < 16; ++i) { sa[st][0][i] = 0.f; sa[st][1][i] = 0.f; }
#pragma unroll
            for (int ks = 0; ks < 4; ++ks) { sa[st][0] = __builtin_amdgcn_mfma_f32_32x32x16_f16(kf[0][ks], qf[ks], sa[st][0], 0, 0, 0);
                                             sa[st][1] = __builtin_amdgcn_mfma_f32_32x32x16_f16(kf[1][ks], qf[ks], sa[st][1], 0, 0, 0); }
        }
    }
    if (!OWN) {
        float mx = fmaxf(fmaxf(sa[0][0][0], sa[0][1][0]), fmaxf(sa[1][0][0], sa[1][1][0]));
#pragma unroll
        for (int i = 1; i < 16; ++i) mx = fmaxf(mx, fmaxf(fmaxf(sa[0][0][i], sa[0][1][i]), fmaxf(sa[1][0][i], sa[1][1][i])));
        mx = fmaxf(mx, __shfl_xor(mx, 32));
        mx = lsel ? mx : -INFINITY;
        if (__any(mx > m_run + 8.0f)) {
            const float m_new = (mx > m_run + 8.0f) ? mx : m_run;
            const float alpha = __builtin_amdgcn_exp2f(m_run - m_new);
            m_run = m_new; l_run *= alpha;
#pragma unroll
            for (int i = 0; i < 16; ++i) { o0[i] *= alpha; o1[i] *= alpha; }
        }
        const float m_eff = lsel ? m_run : INFINITY;
        float ps = 0.f;
#pragma unroll
        for (int st = 0; st < 2; ++st)
#pragma unroll
            for (int sh = 0; sh < 2; ++sh) {
#pragma unroll
                for (int i = 0; i < 16; ++i) { sa[st][sh][i] = __builtin_amdgcn_exp2f(sa[st][sh][i] - m_eff); ps += sa[st][sh][i]; }
#pragma unroll
                for (int s2 = 0; s2 < 2; ++s2) {
                    h16x8 pf;
#pragma unroll
                    for (int j = 0; j < 8; ++j) pf[j] = (h16)sa[st][sh][8 * s2 + j];
                    const LAS h16* vp = Vt0 + vbase + (64 * st + 32 * sh + 16 * s2) * AT_VP;
                    const h16x8 v0 = __builtin_shufflevector(vtr4(vp), vtr4(vp + 4 * AT_VP), 0, 1, 2, 3, 4, 5, 6, 7);
                    const h16x8 v1 = __builtin_shufflevector(vtr4(vp + 32), vtr4(vp + 4 * AT_VP + 32), 0, 1, 2, 3, 4, 5, 6, 7);
                    o0 = __builtin_amdgcn_mfma_f32_32x32x16_f16(v0, pf, o0, 0, 0, 0);
                    o1 = __builtin_amdgcn_mfma_f32_32x32x16_f16(v1, pf, o1, 0, 0, 0); } }
        l_run += ps;
        return;
    }
#pragma unroll
    for (int st = 0; st < 2; ++st) {
        const int j16 = kt * 2 + st;
        if (OWN && 2 * j16 > w) continue;
        const LAS h16* Kt = Kt0 + 64 * st * AT_KP; const LAS h16* Vt = Vt0 + 64 * st * AT_VP + vbase;
        f32x16 s0, s1;
        if (OWN) {
            h16x8 kf[2][4];
#pragma unroll
            for (int sh = 0; sh < 2; ++sh)
#pragma unroll
                for (int ks = 0; ks < 4; ++ks) kf[sh][ks] = *(const LAS h16x8*)(Kt + (32 * sh + sig) * AT_KP + 16 * ks + 8 * hi);
#pragma unroll
            for (int i = 0; i < 16; ++i) { s0[i] = 0.f; s1[i] = 0.f; }
#pragma unroll
            for (int ks = 0; ks < 4; ++ks) { s0 = __builtin_amdgcn_mfma_f32_32x32x16_f16(kf[0][ks], qf[ks], s0, 0, 0, 0);
                                             s1 = __builtin_amdgcn_mfma_f32_32x32x16_f16(kf[1][ks], qf[ks], s1, 0, 0, 0); }
        } else { s0 = sa[st][0]; s1 = sa[st][1]; }
        if (OWN) {
            const int rel0 = 2 * j16 - w;
            if (rel0 == 0) {
#pragma unroll
                for (int i = 0; i < 16; ++i) { const int key = (i & 3) + 4 * ((i >> 2) & 1) + 8 * hi + 16 * (i >> 3); s0[i] = key <= r32 ? s0[i] : -INFINITY; } }
            if (rel0 + 1 > 0) {
#pragma unroll
                for (int i = 0; i < 16; ++i) s1[i] = -INFINITY; }
            else if (rel0 + 1 == 0) {
#pragma unroll
                for (int i = 0; i < 16; ++i) { const int key = (i & 3) + 4 * ((i >> 2) & 1) + 8 * hi + 16 * (i >> 3); s1[i] = key <= r32 ? s1[i] : -INFINITY; } }
        }
        float mx = fmaxf(s0[0], s1[0]);
#pragma unroll
        for (int i = 1; i < 16; ++i) mx = fmaxf(mx, fmaxf(s0[i], s1[i]));
        mx = fmaxf(mx, __shfl_xor(mx, 32));
        if (!OWN) mx = lsel ? mx : -INFINITY;
        if (__any(mx > m_run + 8.0f)) {
            const float m_new = (mx > m_run + 8.0f) ? mx : m_run;
            const float alpha = __builtin_amdgcn_exp2f(m_run - m_new);
            m_run = m_new; l_run *= alpha;
#pragma unroll
            for (int i = 0; i < 16; ++i) { o0[i] *= alpha; o1[i] *= alpha; }
        }
        const float m_eff = (OWN || lsel) ? m_run : INFINITY;
        float ps = 0.f;
#pragma unroll
        for (int i = 0; i < 16; ++i) { s0[i] = __builtin_amdgcn_exp2f(s0[i] - m_eff); s1[i] = __builtin_amdgcn_exp2f(s1[i] - m_eff); ps += s0[i] + s1[i]; }
        l_run += ps;
        h16x8 pf[2][2];
#pragma unroll
        for (int s2 = 0; s2 < 2; ++s2)
#pragma unroll
            for (int j = 0; j < 8; ++j) { pf[0][s2][j] = (h16)s0[8 * s2 + j]; pf[1][s2][j] = (h16)s1[8 * s2 + j]; }
#pragma unroll
        for (int sh = 0; sh < 2; ++sh)
#pragma unroll
            for (int s2 = 0; s2 < 2; ++s2) {
                const LAS h16* vp = Vt + (32 * sh + 16 * s2) * AT_VP;
                const h16x8 v0 = __builtin_shufflevector(vtr4(vp), vtr4(vp + 4 * AT_VP), 0, 1, 2, 3, 4, 5, 6, 7);
                const h16x8 v1 = __builtin_shufflevector(vtr4(vp + 32), vtr4(vp + 4 * AT_VP + 32), 0, 1, 2, 3, 4, 5, 6, 7);
                o0 = __builtin_amdgcn_mfma_f32_32x32x16_f16(v0, pf[sh][s2], o0, 0, 0, 0);
                o1 = __builtin_amdgcn_mfma_f32_32x32x16_f16(v1, pf[sh][s2], o1, 0, 0, 0); }
    }
}
__device__ __forceinline__ void attn_phase(unsigned char* ws, LAS unsigned char* lds, int tid, int lane, int w) {
    const h16* PROJ = (const h16*)(ws + OFF_PROJ); const float* KMEAN = (const float*)(ws + OFF_KMEAN);
    h16* YATT = (h16*)(ws + OFF_YATT);
    { const float* AGG = (const float*)(ws + OFF_AGG); float* CARRY = (float*)(ws + OFF_CARRY);
      for (int sc = blockIdx.x * 8 + w; sc < B_ * 256; sc += gridDim.x * 8) {
          const int b = sc >> 8, cj = sc & 255;
          const size_t o0 = ((size_t)b * 128 + 2 * lane) * 256 + cj, o1 = o0 + 256;
          const f32x2 g0 = *(const f32x2*)(AGG + o0 * 2), g1 = *(const f32x2*)(AGG + o1 * 2);
          float A = g0.x * g1.x, H = g1.x * g0.y + g1.y;
#pragma unroll
          for (int d = 1; d < 64; d <<= 1) { const float Ap = __shfl_up(A, d), Hp = __shfl_up(H, d); if (lane >= d) { H = A * Hp + H; A = A * Ap; } }
          float He = __shfl_up(H, 1); if (lane == 0) He = 0.f;
          CARRY[o0] = He; CARRY[o1] = g0.x * He + g0.y; } }
    const int r32 = lane & 31, hi = lane >> 5;
    LAS h16* Kb = (LAS h16*)lds; LAS h16* Vb = (LAS h16*)(lds + 2 * AT_KB * 2); LAS float* KM = (LAS float*)(lds + 2 * AT_KB * 2 + 2 * AT_VB * 2);
    const int srow = tid >> 3, sch = tid & 7;
    const int sig = (r32 & 19) | ((r32 & 4) << 1) | ((r32 & 8) >> 1);
    const int vbase = (8 * hi + ((lane & 15) >> 2)) * AT_VP + 16 * ((lane >> 4) & 1) + 4 * (lane & 3);
    for (int it = blockIdx.x; it < 1024; it += gridDim.x) {
        int own, bh;
        if (gridDim.x == 256) { const int rnd = it >> 8, xcd = it & 7, i5 = (it >> 3) & 31; bh = xcd * 8 + 2 * rnd + (i5 >> 4); own = (rnd & 1) ? (i5 & 15) : 15 - (i5 & 15); }
        else { const int rnd = it >> 8, c = it & 255, g = c >> 6; bh = c & 63; own = rnd == 0 ? 15 - g : rnd == 1 ? 8 + g : rnd == 2 ? 7 - g : g; }
        const int b = bh >> 3, h = bh & 7;
        __syncthreads();
        { const f32x2 kv = *(const f32x2*)(KMEAN + (size_t)bh * 1024 + 2 * tid); KM[2 * tid] = kv.x; KM[2 * tid + 1] = kv.y; }
        const size_t tokq = (size_t)b * S_ + own * 256 + 32 * w + r32;
        const h16* qrow = PROJ + tokq * NPROJ + C_Q + h * 64 + 8 * hi;
        h16x8 qf[4];
#pragma unroll
        for (int ks = 0; ks < 4; ++ks) qf[ks] = *(const h16x8*)(qrow + 16 * ks);
        const h16* kg = PROJ + ((size_t)b * S_ + srow) * NPROJ + C_K + h * 64 + sch * 8;
        const int T = 2 * (own + 1);
#define AT_TOK(ti) (((ti) < 2 ? own : (((ti) - 2) >> 1)) * 256 + ((ti) & 1) * 128)
#define AT_LOAD(R, ti) do { const h16* p_ = kg + (size_t)AT_TOK(ti) * NPROJ; R[0] = *(const u32x4*)p_; R[1] = *(const u32x4*)(p_ + (size_t)64 * NPROJ); \
        R[2] = *(const u32x4*)(p_ + (C_V - C_K)); R[3] = *(const u32x4*)(p_ + (size_t)64 * NPROJ + (C_V - C_K)); } while (0)
#define AT_STORE(R, buf) do { LAS h16* kd_ = Kb + (buf) * AT_KB + srow * AT_KP + sch * 8; LAS h16* vd_ = Vb + (buf) * AT_VB + srow * AT_VP + sch * 8; \
        *(LAS u32x4*)kd_ = R[0]; *(LAS u32x4*)(kd_ + 64 * AT_KP) = R[1]; *(LAS u32x4*)vd_ = R[2]; *(LAS u32x4*)(vd_ + 64 * AT_VP) = R[3]; } while (0)
        u32x4 R[4];
        AT_LOAD(R, 0);
        __syncthreads();
        unsigned sel = 0;
        {
            float b0 = -INFINITY, b1 = -INFINITY, b2 = -INFINITY; int i0 = -1, i1 = -1, i2 = -1;
#pragma unroll 1
            for (int n = 0; n < own; ++n) {
                float sc = 0.f;
#pragma unroll
                for (int ks = 0; ks < 4; ++ks)
#pragma unroll
                    for (int jj = 0; jj < 2; ++jj) { const f32x4 kmv = *(const LAS f32x4*)(KM + n * 64 + 16 * ks + 8 * hi + 4 * jj);
                        sc += (float)qf[ks][4 * jj + 0] * kmv.x + (float)qf[ks][4 * jj + 1] * kmv.y + (float)qf[ks][4 * jj + 2] * kmv.z + (float)qf[ks][4 * jj + 3] * kmv.w; }
                sc += __shfl_xor(sc, 32);
                const bool g0 = sc > b0, g1 = sc > b1, g2 = sc > b2;
                b2 = g1 ? b1 : (g2 ? sc : b2); i2 = g1 ? i1 : (g2 ? n : i2);
                b1 = g0 ? b0 : (g1 ? sc : b1); i1 = g0 ? i0 : (g1 ? n : i1);
                b0 = g0 ? sc : b0;             i0 = g0 ? n : i0;
            }
            if (i0 >= 0) sel |= 1u << i0;
            if (i1 >= 0) sel |= 1u << i1;
            if (i2 >= 0) sel |= 1u << i2;
        }
        AT_STORE(R, 0);
        AT_LOAD(R, 1);
        __syncthreads();
        float m_run = -INFINITY, l_run = 0.f;
        f32x16 o0, o1;
#pragma unroll
        for (int i = 0; i < 16; ++i) { o0[i] = 0.f; o1[i] = 0.f; }
        for (int ti = 0; ti < T; ++ti) {
            const int buf = ti & 1;
            AT_STORE(R, buf ^ 1);
            { const int tn = (ti + 2 < T) ? ti + 2 : T - 1; AT_LOAD(R, tn); }
            const int blk = ti < 2 ? own : (ti - 2) >> 1; const bool isown = (blk == own), lsel = isown || ((sel >> blk) & 1u);
            if (isown) attn_tile<true>(Kb + buf * AT_KB, Vb + buf * AT_VB, qf, o0, o1, m_run, l_run, true, ti & 1, w, r32, hi, sig, vbase);
            else if (__ballot(lsel) != 0ull) attn_tile<false>(Kb + buf * AT_KB, Vb + buf * AT_VB, qf, o0, o1, m_run, l_run, lsel, ti & 1, w, r32, hi, sig, vbase);
            WG_BAR();
        }
#undef AT_TOK
#undef AT_LOAD
#undef AT_STORE
        l_run += __shfl_xor(l_run, 32);
        const float inv = 1.0f / l_run;
        h16* orow = YATT + tokq * 512 + h * 64 + 4 * hi;
#pragma unroll
        for (int q = 0; q < 4; ++q) {
            u32x2 w0; w0.x = pkh(o0[4 * q] * inv, o0[4 * q + 1] * inv); w0.y = pkh(o0[4 * q + 2] * inv, o0[4 * q + 3] * inv);
            u32x2 w1; w1.x = pkh(o1[4 * q] * inv, o1[4 * q + 1] * inv); w1.y = pkh(o1[4 * q + 2] * inv, o1[4 * q + 3] * inv);
            *(u32x2*)(orow + 8 * q) = w0; *(u32x2*)(orow + 32 + 8 * q) = w1; }
    }
}

__device__ __forceinline__ float gelu_tanh(float x) { const float z = 0.7978845608028654f * (x + 0.044715f * x * x * x); const float t = 1.0f - 2.0f / (__expf(2.0f * z) + 1.0f); return 0.5f * x * (1.0f + t); }
__device__ __forceinline__ void mixnorm_phase(unsigned char* ws, int l, int gw, int NGW, int lane) {
    const float* PB = (const float*)(ws + OFF_PB) + (size_t)l * PB_LAYER;
    const h16* PROJ = (const h16*)(ws + OFF_PROJ); const h16* YATT = (const h16*)(ws + OFF_YATT);
    const h16* HLOC = (const h16*)(ws + OFF_HLOC); const h16* PCUM = (const h16*)(ws + OFF_PCUM); const float* CARRY = (const float*)(ws + OFF_CARRY);
    h16* Y = (h16*)(ws + OFF_Y);
    const float* mg = PB + PB_MIXG; const float* scw = PB + PB_SCW;
    for (int tok0 = gw * 2; tok0 < M_; tok0 += NGW * 2) {
        float fa[2][8], yc[2][4], yl[2][4], ssa[2], ssc[2], ssl[2];
#pragma unroll
        for (int u = 0; u < 2; ++u) {
            const int tok = tok0 + u; const int b = tok >> 12, t = tok & 4095, chn = t >> 5;
            const h16x8 ya = *(const h16x8*)(YATT + (size_t)tok * 512 + 8 * lane);
            float sa_ = 0.f;
#pragma unroll
            for (int j = 0; j < 8; ++j) { fa[u][j] = (float)ya[j]; sa_ += fa[u][j] * fa[u][j]; }
            ssa[u] = sa_;
            const h16* pr = PROJ + (size_t)tok * NPROJ;
            const h16x4 bb = *(const h16x4*)(pr + C_SCB + 4 * lane);
            f32x4 conv = {0.f, 0.f, 0.f, 0.f};
#pragma unroll
            for (int k = 0; k < 3; ++k) { if (t - 2 + k >= 0) { const h16* pk = pr + (k - 2) * NPROJ;
                const h16x4 cc = *(const h16x4*)(pk + C_SCC + 4 * lane), uu = *(const h16x4*)(pk + C_SCU + 4 * lane);
                const f32x4 wv = *(const f32x4*)(scw + k * 256 + 4 * lane);
#pragma unroll
                for (int j = 0; j < 4; ++j) conv[j] += wv[j] * ((float)cc[j] * (float)uu[j]); } }
            float sc_ = 0.f;
#pragma unroll
            for (int j = 0; j < 4; ++j) { yc[u][j] = (float)bb[j] * conv[j]; sc_ += yc[u][j] * yc[u][j]; }
            ssc[u] = sc_;
            const h16x4 hl = *(const h16x4*)(HLOC + (size_t)tok * 256 + 4 * lane), pc = *(const h16x4*)(PCUM + (size_t)tok * 256 + 4 * lane);
            const f32x4 cr = *(const f32x4*)(CARRY + ((size_t)b * 128 + chn) * 256 + 4 * lane);
            const h16x4 lg = *(const h16x4*)(pr + C_LG + 4 * lane);
            float sl_ = 0.f;
#pragma unroll
            for (int j = 0; j < 4; ++j) { const float hv = (float)hl[j] + (float)pc[j] * cr[j]; yl[u][j] = hv * gelu_tanh((float)lg[j]); sl_ += yl[u][j] * yl[u][j]; }
            ssl[u] = sl_;
        }
#pragma unroll
        for (int o = 1; o < 64; o <<= 1) {
#pragma unroll
            for (int u = 0; u < 2; ++u) { ssa[u] += __shfl_xor(ssa[u], o); ssc[u] += __shfl_xor(ssc[u], o); ssl[u] += __shfl_xor(ssl[u], o); } }
        const f32x4 ga0 = *(const f32x4*)(mg + 8 * lane), ga1 = *(const f32x4*)(mg + 8 * lane + 4), gc = *(const f32x4*)(mg + 512 + 4 * lane), gl = *(const f32x4*)(mg + 768 + 4 * lane);
#pragma unroll
        for (int u = 0; u < 2; ++u) {
            const float ra = rsqrtf(ssa[u] * (1.0f / 512.0f) + EPS_), rc = rsqrtf(ssc[u] * (1.0f / 256.0f) + EPS_), rl = rsqrtf(ssl[u] * (1.0f / 256.0f) + EPS_);
            h16* yo = Y + (size_t)(tok0 + u) * 1024;
            { u32x4 o; o.x = pkh(fa[u][0] * ra * ga0.x, fa[u][1] * ra * ga0.y); o.y = pkh(fa[u][2] * ra * ga0.z, fa[u][3] * ra * ga0.w);
              o.z = pkh(fa[u][4] * ra * ga1.x, fa[u][5] * ra * ga1.y); o.w = pkh(fa[u][6] * ra * ga1.z, fa[u][7] * ra * ga1.w);
              *(u32x4*)(yo + 8 * lane) = o; }
            { u32x2 o; o.x = pkh(yc[u][0] * rc * gc.x, yc[u][1] * rc * gc.y); o.y = pkh(yc[u][2] * rc * gc.z, yc[u][3] * rc * gc.w);
              *(u32x2*)(yo + 512 + 4 * lane) = o; }
            { u32x2 o; o.x = pkh(yl[u][0] * rl * gl.x, yl[u][1] * rl * gl.y); o.y = pkh(yl[u][2] * rl * gl.z, yl[u][3] * rl * gl.w);
              *(u32x2*)(yo + 768 + 4 * lane) = o; }
        }
    }
}

#define XB_TMO      128
#define XB_XCNT(j)  (256  + 64 * (j))
#define XB_XSUB(j)  (1280 + 64 * (j))
#define XB_XGEN(j)  (2304 + 64 * (j))
#define XB_TOP      3328
#define XB_TOPGEN   3392
#define XCD_BAR_WORDS 3456
#define XB_SPIN_CAP (1u << 18)

__device__ __forceinline__ unsigned xb_ld(unsigned* p)              { return __hip_atomic_load(p, __ATOMIC_RELAXED, __HIP_MEMORY_SCOPE_AGENT); }
__device__ __forceinline__ unsigned xb_add(unsigned* p, unsigned v) { return __hip_atomic_fetch_add(p, v, __ATOMIC_RELAXED, __HIP_MEMORY_SCOPE_AGENT); }
__device__ __forceinline__ unsigned xb_xcc_id() { return (unsigned)__builtin_amdgcn_s_getreg((3 << 11) | 20) & 0xFu; }
#define XB_SPIN(cond, bar) do { unsigned _sp = 0; while (cond) { __builtin_amdgcn_s_sleep(1); \
    if ((++_sp & 255u) == 0u) { if (xb_ld(&(bar)[XB_TMO])) break; if (_sp > XB_SPIN_CAP) { atomicAdd(&(bar)[XB_TMO], 1u); break; } } } } while (0)

struct XcdBarrier {
    unsigned* bar; unsigned x;
    volatile LAS unsigned* st;
};

__device__ __forceinline__ XcdBarrier xcd_barrier_post(unsigned* bar, volatile LAS unsigned* st) {
    XcdBarrier b; b.bar = bar; b.x = xb_xcc_id(); b.st = st;
    if (threadIdx.x == 0) (void)xb_add(&bar[XB_XCNT(b.x)], 1u);
    return b;
}
__device__ __forceinline__ void xcd_barrier_complete(unsigned* bar, unsigned x, unsigned& nloc, unsigned& nx) {
    const unsigned G = gridDim.x * gridDim.y * gridDim.z;
    unsigned sum, cnt, mine, sp = 0u;
    for (;;) {
        sum = 0u; cnt = 0u; mine = 0u;
#pragma unroll
        for (unsigned j = 0; j < 16; ++j) { const unsigned c = xb_ld(&bar[XB_XCNT(j)]); sum += c; cnt += (c > 0u) ? 1u : 0u; mine = (j == x) ? c : mine; }
        if (sum == G) break;
        __builtin_amdgcn_s_sleep(1);
        if ((++sp & 255u) == 0u) { if (xb_ld(&bar[XB_TMO])) break; if (sp > XB_SPIN_CAP) { atomicAdd(&bar[XB_TMO], 1u); break; } }
    }
    nloc = mine > 0u ? mine : 1u; nx = cnt > 0u ? cnt : 1u;
}

__device__ __forceinline__ void xcd_barrier(const XcdBarrier& b) {
    asm volatile("s_waitcnt vmcnt(0)" ::: "memory");
    __syncthreads();
    if (threadIdx.x == 0) {
        unsigned* bar = b.bar;
        __builtin_amdgcn_s_waitcnt(0);
        unsigned nloc = b.st[0], nx = b.st[1];
        if (nloc == 0u) { xcd_barrier_complete(bar, b.x, nloc, nx); b.st[0] = nloc; b.st[1] = nx; }
        const unsigned old = xb_add(&bar[XB_XSUB(b.x)], 1u);
        const unsigned gen = old / nloc;
        if (old + 1u == (gen + 1u) * nloc) {
            __builtin_amdgcn_fence(__ATOMIC_RELEASE, "agent");
            asm volatile("s_waitcnt vmcnt(0)" ::: "memory");
            const unsigned og = xb_add(&bar[XB_TOP], 1u);
            const unsigned tg = og / nx;
            if (og + 1u == (tg + 1u) * nx) xb_add(&bar[XB_TOPGEN], 1u);
            else XB_SPIN(xb_ld(&bar[XB_TOPGEN]) == tg, bar);
            __builtin_amdgcn_fence(__ATOMIC_ACQUIRE, "agent");
            xb_add(&bar[XB_XGEN(b.x)], 1u);
            asm volatile("s_waitcnt vmcnt(0)" ::: "memory");
        } else {
            XB_SPIN(xb_ld(&bar[XB_XGEN(b.x)]) == gen, bar);
            __builtin_amdgcn_fence(__ATOMIC_ACQUIRE, "agent");
            asm volatile("s_waitcnt vmcnt(0)" ::: "memory");
        }
    }
    __syncthreads();
}

struct EpiAny {
    static constexpr bool PERM = true, AFTER_DRAIN = false;
    unsigned char* ws; const float* xptr; float* optr; int l, k;
    __device__ __forceinline__ void operator()(const pg8::f32x4 (&acc)[2][2][4][2], const pg8::Unit& u, int wr, int wc, int fr, int fq) const {
        const float* PBl = (const float*)(ws + OFF_PB) + (size_t)l * PB_LAYER; const float* modl = (const float*)(ws + OFF_MOD) + (size_t)l * 8 * 6144;
        if (k == 1) { const pg8::EpiInProj E{(pg8::bf16_t*)(ws + OFF_PROJ), PBl + PB_QG, PBl + PB_KG, (float*)(ws + OFF_KMEAN), QSCALE}; E(acc, u, wr, wc, fr, fq); }
        else if (k == 7) { const pg8::EpiH16<1> E{(pg8::bf16_t*)(ws + OFF_HID), FF_}; E(acc, u, wr, wc, fr, fq); }
        else { const bool dn = (k == 8), last = dn && (l == NL_ - 1), first = !dn && (l == 0); h16* XA = (h16*)(ws + OFF_XA);
            const pg8::EpiRes16 E{first ? (const void*)xptr : (const void*)XA, last ? (void*)optr : (void*)XA, D_, modl + (dn ? 5 : 2) * 1024, 6144, first ? 1 : 0, last ? 1 : 0}; E(acc, u, wr, wc, fr, fq); }
    }
};

#define OPQ_S(x) asm volatile("" : "+s"(x))
#define OPQ_V(x) asm volatile("" : "+v"(x))
__global__ void __launch_bounds__(512, 2) fwd_kernel(Args a) {
    extern __shared__ __attribute__((aligned(16))) unsigned char lds_raw[];
    cg::grid_group grid = cg::this_grid();
    LAS unsigned char* lds = (LAS unsigned char*)lds_raw;
    volatile LAS unsigned* barst = (volatile LAS unsigned*)(lds + LDS_BARST);
    if (threadIdx.x < 2) barst[threadIdx.x] = 0u;
    __syncthreads();
    XcdBarrier xbar = xcd_barrier_post((unsigned*)(a.ws + OFF_BAR), barst);
    { const int tid = threadIdx.x, lane = tid & 63, wave = __builtin_amdgcn_readfirstlane(tid >> 6);
      p0_phase(a, lds, tid, lane, wave); }
    grid.sync();
    const float* xptr = a.in[I_X]; float* optr = a.out; unsigned char* wsb = a.ws;
#pragma unroll 1
    for (int step = 0; step < 9 * NL_; ++step) {
        const int l = step / 9, k = step - 9 * l;
#define PH_BEGIN GAS unsigned char* wsg_ = (GAS unsigned char*)wsb; OPQ_S(wsg_); unsigned char* ws = (unsigned char*)wsg_;     int tid = threadIdx.x; OPQ_V(tid); const int lane = tid & 63, wave = __builtin_amdgcn_readfirstlane(tid >> 6); \
        const int G = gridDim.x, gw = blockIdx.x * 8 + wave, NGW = G * 8; (void)gw; (void)NGW; (void)lane; \
        const float* modl = (const float*)(ws + OFF_MOD) + (size_t)l * 8 * 6144; const unsigned char* wl = ws + OFF_W + (size_t)l * W_LAYER; (void)modl; (void)wl; \
        h16* H = (h16*)(ws + OFF_H); h16* XA = (h16*)(ws + OFF_XA); (void)H; (void)XA;
        { PH_BEGIN
          const float* PBl = (const float*)(ws + OFF_PB) + (size_t)l * PB_LAYER;
          if (k == 0 || k == 6) {
              const float* gp = PBl + (k == 0 ? PB_LN1G : PB_LN2G); const int shc = (k == 0) ? 0 : 3, scc = (k == 0) ? 1 : 4;
              ln_phase(step != 0, step == 0 ? (const void*)xptr : (const void*)XA, gp, modl, shc, scc, H, gw, NGW, lane);
          } else if (k == 2) { lru_phase(ws, l, lds, lane, wave);
          } else if (k == 3) { attn_phase(ws, lds, tid, lane, wave);
          } else if (k == 4) { mixnorm_phase(ws, l, gw, NGW, lane);
          } else {
              const unsigned char* Ap = ws + (k == 5 ? OFF_Y : k == 8 ? OFF_HID : OFF_H);
              const unsigned char* Bp = wl + (k == 1 ? W_IN : k == 5 ? W_OUT : k == 7 ? W_UP : W_DOWN);
              const int Ng = (k == 1) ? NPROJ : (k == 7) ? FF_ : D_, Kg = (k == 8) ? FF_ : D_;
              pg8::Gemm g{(const pg8::bf16_t*)Ap, (const pg8::bf16_t*)Bp, M_, Ng, Kg}; pg8::StaticOrder S; S.init(M_, Ng, G, (int)blockIdx.x);
              EpiAny E{ws, xptr, optr, l, k};
              pg8::gemm_phase<EpiAny, pg8::StaticOrder, true, true>(lds, g, S, E);
          }
        }
        if (step + 1 < 9 * NL_) xcd_barrier(xbar);
    }
}

extern "C" void kernel_launch(void* const* d_in, const int* in_sizes, int n_in, void* d_out, int out_size, void* d_ws, size_t ws_size, hipStream_t stream) {
    static int grid = 0;
    if (grid == 0) {
        if (n_in != 21 || out_size != M_ * D_ || ws_size < WS_END) { fprintf(stderr, "kernel_launch: unexpected shapes (n_in %d out %d ws %zu)\n", n_in, out_size, ws_size); grid = -1; return; }
        int dev = 0, cus = 0, per_cu = 0;
        (void)hipGetDevice(&dev);
        (void)hipDeviceGetAttribute(&cus, hipDeviceAttributeMultiprocessorCount, dev);
        (void)hipFuncSetAttribute((const void*)fwd_kernel, hipFuncAttributeMaxDynamicSharedMemorySize, LDS_BYTES);
        if (hipOccupancyMaxActiveBlocksPerMultiprocessor(&per_cu, (const void*)fwd_kernel, 512, LDS_BYTES) != hipSuccess || per_cu < 1) per_cu = 1;
        (void)hipGetLastError();
        grid = cus * per_cu;
    }
    if (grid < 0) return;
    Args a{};
    for (int i = 0; i < 21; ++i) a.in[i] = (const float*)d_in[i];
    a.out = (float*)d_out; a.ws = (unsigned char*)d_ws;
    (void)hipMemsetAsync((unsigned char*)d_ws + OFF_BAR, 0, BAR_BYTES, stream);
    void* args[] = {&a};
    hipError_t e = hipLaunchCooperativeKernel((const void*)fwd_kernel, dim3(grid), dim3(512), args, LDS_BYTES, stream);
    if (e != hipSuccess) fprintf(stderr, "cooperative launch failed: %s (grid %d)\n", hipGetErrorString(e), grid);
}
```

```cpp
#include <hip/hip_runtime.h>
#include <hip/hip_cooperative_groups.h>
#include <cstdio>
#include <cstdint>
namespace cg = cooperative_groups;
namespace pg8 {
#define PG8_LAS __attribute__((address_space(3)))
typedef unsigned short bf16_t;
typedef _Float16 bf16x8 __attribute__((ext_vector_type(8)));
typedef float f32x4 __attribute__((ext_vector_type(4)));
typedef unsigned u32x4 __attribute__((ext_vector_type(4)));
constexpr int BM = 256, BK = 64, HALF = 128, HTB = HALF * BK * 2  , STAGE_BYTES = 8 * HTB, NXCD = 8, WGM = 4;

__host__ __device__ __forceinline__ int lds_byte(int r, int c) { const int st = (r >> 4) * 2 + (c >> 5), rr = r & 15, cc = c & 31, ob = rr * 64 + cc * 2; return st * 1024 + (ob ^ (((ob >> 9) & 1) << 5)); }
__host__ __device__ __forceinline__ void stage_rc(int b, int& R, int& C) { const int st = b / 1024, sb = b % 1024, swz = sb ^ (((sb >> 9) & 1) << 5); R = (st >> 1) * 16 + swz / 64; C = (st & 1) * 32 + (swz % 64) / 2; }
__host__ __device__ __forceinline__ int perm32(int rho) { const int n = rho >> 4, i = rho & 15; return 8 * (i >> 2) + 4 * n + (i & 3); }

struct Unit { int pm, pn; };
struct Gemm { const bf16_t* A; const bf16_t* Bt; int M, N, K; };

struct StaticOrder {
    int nM, nN, nwg, G, c;
    __host__ __device__ void init(int M, int N, int G_, int c_) { nM = M / BM; nN = N / BM; nwg = nM * nN; G = G_; c = c_; }
    __host__ __device__ bool next(int i, Unit& u) const {
        const long L = (long)i * G + c; if (L >= nwg) return false;
        int wgid = (int)L; { const int q = nwg / NXCD, r = nwg % NXCD, xcd = wgid % NXCD, off = wgid / NXCD; wgid = (xcd < r ? xcd * (q + 1) : r * (q + 1) + (xcd - r) * q) + off; }
        const int nig = WGM * nN, gid = wgid / nig, fm = gid * WGM, gsz = (nM - fm) < WGM ? (nM - fm) : WGM;
        u.pm = fm + ((wgid % nig) % gsz); u.pn = (wgid % nig) / gsz; return true;
    }
    __device__ __forceinline__ void a_ready(const Unit&) const {}
    __device__ __forceinline__ void done(const Unit&) const {}
};
typedef float f32x2 __attribute__((ext_vector_type(2)));
typedef _Float16 h16x2 __attribute__((ext_vector_type(2)));
__device__ __forceinline__ unsigned pk_h2(float lo, float hi) { f32x2 v = {lo, hi}; h16x2 h = __builtin_convertvector(v, h16x2); return __builtin_bit_cast(unsigned, h); }
template <int ACT  > struct EpiH16 {
    static constexpr bool PERM = true, AFTER_DRAIN = false;
    bf16_t* O; int ldc;
    __device__ __forceinline__ void operator()(const f32x4 (&acc)[2][2][4][2], const Unit& u, int wr, int wc, int fr, int fq) const {
        const int row0 = u.pm * BM + wr * 64 + fr; const int col0 = u.pn * BM + wc * 32 + 8 * fq;
#pragma unroll
        for (int ai = 0; ai < 2; ++ai)
#pragma unroll
            for (int m = 0; m < 4; ++m) { bf16_t* rowp = O + (size_t)(row0 + ai * HALF + m * 16) * ldc + col0;
#pragma unroll
                for (int bj = 0; bj < 2; ++bj) { f32x4 v0 = acc[ai][bj][m][0], v1 = acc[ai][bj][m][1];
                    if (ACT == 1) {
#pragma unroll
                        for (int j = 0; j < 4; ++j) { float a = v0[j] > 0.f ? v0[j] : 0.f; v0[j] = a * a; float b = v1[j] > 0.f ? v1[j] : 0.f; v1[j] = b * b; } }
                    u32x4 w; w.x = pk_h2(v0[0], v0[1]); w.y = pk_h2(v0[2], v0[3]); w.z = pk_h2(v1[0], v1[1]); w.w = pk_h2(v1[2], v1[3]);
                    *(u32x4*)(rowp + bj * HALF) = w; } }
    }
};
struct EpiRes {
    static constexpr bool PERM = false, AFTER_DRAIN = false;
    const float* base; float* out; int ldc; const float* gate; int gstride;
    __device__ __forceinline__ void operator()(const f32x4 (&acc)[2][2][4][2], const Unit& u, int wr, int wc, int fr, int fq) const {
        const int row0 = u.pm * BM + wr * 64 + fr, col0 = u.pn * BM + wc * 32 + 4 * fq;
        const float* gp = gate + (size_t)(u.pm >> 4) * gstride + col0;
        f32x4 gv[2][2];
#pragma unroll
        for (int bj = 0; bj < 2; ++bj)
#pragma unroll
            for (int n = 0; n < 2; ++n) gv[bj][n] = *(const f32x4*)(gp + bj * HALF + n * 16);
#pragma unroll
        for (int ai = 0; ai < 2; ++ai)
#pragma unroll
            for (int m = 0; m < 4; ++m) { const size_t off = (size_t)(row0 + ai * HALF + m * 16) * ldc + col0;
#pragma unroll
                for (int bj = 0; bj < 2; ++bj)
#pragma unroll
                    for (int n = 0; n < 2; ++n) { const f32x4 bs = *(const f32x4*)(base + off + bj * HALF + n * 16);
                        *(f32x4*)(out + off + bj * HALF + n * 16) = bs + gv[bj][n] * acc[ai][bj][m][n]; } }
    }
};

struct EpiRes16 {
    static constexpr bool PERM = true, AFTER_DRAIN = false;
    const void* base; void* out; int ldc; const float* gate; int gstride; int base_f32, out_f32;
    __device__ __forceinline__ void operator()(const f32x4 (&acc)[2][2][4][2], const Unit& u, int wr, int wc, int fr, int fq) const {
        const int row0 = u.pm * BM + wr * 64 + fr, col0 = u.pn * BM + wc * 32 + 8 * fq;
        const float* gp = gate + (size_t)(u.pm >> 4) * gstride + col0;
        f32x4 gv[2][2];
#pragma unroll
        for (int bj = 0; bj < 2; ++bj)
#pragma unroll
            for (int n = 0; n < 2; ++n) gv[bj][n] = *(const f32x4*)(gp + bj * HALF + 4 * n);
#pragma unroll
        for (int ai = 0; ai < 2; ++ai)
#pragma unroll
            for (int m = 0; m < 4; ++m) { const size_t off = (size_t)(row0 + ai * HALF + m * 16) * ldc + col0;
#pragma unroll
                for (int bj = 0; bj < 2; ++bj) {
                    f32x4 b0, b1;
                    if (base_f32) { const float* bp = (const float*)base + off + bj * HALF; b0 = *(const f32x4*)bp; b1 = *(const f32x4*)(bp + 4); }
                    else { const bf16x8 hv = *(const bf16x8*)((const bf16_t*)base + off + bj * HALF);
                        b0 = (f32x4){(float)hv[0], (float)hv[1], (float)hv[2], (float)hv[3]}; b1 = (f32x4){(float)hv[4], (float)hv[5], (float)hv[6], (float)hv[7]}; }
                    const f32x4 y0 = b0 + gv[bj][0] * acc[ai][bj][m][0], y1 = b1 + gv[bj][1] * acc[ai][bj][m][1];
                    if (out_f32) { float* op = (float*)out + off + bj * HALF; *(f32x4*)op = y0; *(f32x4*)(op + 4) = y1; }
                    else { u32x4 w; w.x = pk_h2(y0[0], y0[1]); w.y = pk_h2(y0[2], y0[3]); w.z = pk_h2(y1[0], y1[1]); w.w = pk_h2(y1[2], y1[3]);
                        *(u32x4*)((bf16_t*)out + off + bj * HALF) = w; } } }
    }
};
struct EpiInProj {
    static constexpr bool PERM = true, AFTER_DRAIN = false;
    bf16_t* O; const float* qg; const float* kg; float* kmean; float qscale;
    __device__ __forceinline__ void operator()(const f32x4 (&acc)[2][2][4][2], const Unit& u, int wr, int wc, int fr, int fq) const {
        constexpr int LDC = 2816;
        int fr_ = fr, fq_ = fq; asm volatile("" : "+v"(fr_), "+v"(fq_));
        const int row0 = u.pm * BM + wr * 64 + fr_;
        if (u.pn >= 4) {
            const int col0 = u.pn * BM + wc * 32 + 8 * fq_;
#pragma unroll
            for (int ai = 0; ai < 2; ++ai)
#pragma unroll
                for (int m = 0; m < 4; ++m) { bf16_t* rowp = O + (size_t)(row0 + ai * HALF + m * 16) * LDC + col0;
#pragma unroll
                    for (int bj = 0; bj < 2; ++bj) { const f32x4 v0 = acc[ai][bj][m][0], v1 = acc[ai][bj][m][1];
                        u32x4 w; w.x = pk_h2(v0[0], v0[1]); w.y = pk_h2(v0[2], v0[3]); w.z = pk_h2(v1[0], v1[1]); w.w = pk_h2(v1[2], v1[3]);
                        *(u32x4*)(rowp + bj * HALF) = w; } }
        } else {
            const bool isk = u.pn >= 2;
            const float* gp = (isk ? kg : qg) + 8 * fq_; const float gs = isk ? 1.0f : qscale;
            f32x4 gv[2][2];
#pragma unroll
            for (int bj = 0; bj < 2; ++bj)
#pragma unroll
                for (int n = 0; n < 2; ++n) gv[bj][n] = *(const f32x4*)(gp + 32 * bj + 4 * n) * gs;
            const int col0 = u.pn * BM + wc * 64 + 8 * fq_;
#pragma unroll
            for (int ai = 0; ai < 2; ++ai)
#pragma unroll
                for (int m = 0; m < 4; ++m) {
                    float ss = 0.f;
#pragma unroll
                    for (int bj = 0; bj < 2; ++bj)
#pragma unroll
                        for (int n = 0; n < 2; ++n) { const f32x4 v = acc[ai][bj][m][n]; ss += (v[0] * v[0] + v[1] * v[1]) + (v[2] * v[2] + v[3] * v[3]); }
                    ss += __shfl_xor(ss, 16); ss += __shfl_xor(ss, 32);
                    const float r = rsqrtf(ss * (1.0f / 64.0f) + 1e-6f);
                    bf16_t* rowp = O + (size_t)(row0 + ai * HALF + m * 16) * LDC + col0;
#pragma unroll
                    for (int bj = 0; bj < 2; ++bj) { const f32x4 y0 = acc[ai][bj][m][0] * r * gv[bj][0], y1 = acc[ai][bj][m][1] * r * gv[bj][1];
                        u32x4 w; w.x = pk_h2(y0[0], y0[1]); w.y = pk_h2(y0[2], y0[3]); w.z = pk_h2(y1[0], y1[1]); w.w = pk_h2(y1[2], y1[3]);
                        *(u32x4*)(rowp + 32 * bj) = w; }
                    asm volatile("" ::: "memory"); }
        }
    }
};

template <class Epi, class Sched, bool ALIGN_EPI = false, bool SP2 = false>
__device__ __forceinline__ void gemm_phase(PG8_LAS unsigned char* lds, const Gemm g, const Sched& S, const Epi& E) {
    int tid_ = threadIdx.x; asm volatile("" : "+v"(tid_));
    const int tid = tid_, wid = __builtin_amdgcn_readfirstlane(tid >> 6), lane = tid & 63, wr = wid >> 2, wc = wid & 3, fr = lane & 15, fq = lane >> 4;
    const int K = g.K, nt = K / BK;
    unsigned voffA[2], voffB[2];
#pragma unroll
    for (int i = 0; i < 2; ++i) { int R, C; stage_rc(tid * 16 + i * 8192, R, C); const int Rb = Epi::PERM ? ((R & ~31) + perm32(R & 31)) : R;
        voffA[i] = (unsigned)(R * K + C) * 2u; voffB[i] = (unsigned)(Rb * K + C) * 2u; }
    const size_t kstep = (size_t)(BK * 2);
    const size_t hstep = (size_t)HALF * K * 2;
    const size_t tstep = 2 * hstep;
    const unsigned ldsw = (unsigned)wid * 1024u;
    const int aoff = lds_byte(wr * 64 + fr, fq * 8), boff = lds_byte(wc * 32 + fr, fq * 8);
#define PG8_SA(b, h) (((b) * 2 + (h)) * HTB)
#define PG8_SB(b, h) ((4 + (b) * 2 + (h)) * HTB)
#define PG8_STAGE(bufoff, gbase, voff) do { _Pragma("unroll") for (int _i = 0; _i < 2; ++_i) \
        __builtin_amdgcn_global_load_lds((const unsigned*)((const char*)(gbase) + (voff)[_i]), (PG8_LAS unsigned*)(lds + (bufoff) + ldsw + _i * 8192), 16, 0, 0); } while (0)
#define PG8_LDA(dst, b, h) do { _Pragma("unroll") for (int m = 0; m < 4; ++m) _Pragma("unroll") for (int k = 0; k < 2; ++k) dst[m][k] = *(const PG8_LAS bf16x8*)(lds + PG8_SA(b, h) + aoff + m * 2048 + k * 1024); } while (0)
#define PG8_LDB(dst, b, h) do { _Pragma("unroll") for (int n = 0; n < 2; ++n) _Pragma("unroll") for (int k = 0; k < 2; ++k) dst[n][k] = *(const PG8_LAS bf16x8*)(lds + PG8_SB(b, h) + boff + n * 2048 + k * 1024); } while (0)
#define PG8_MMA(ai, bj, At, Bt) do { __builtin_amdgcn_s_setprio(1); _Pragma("unroll") for (int m = 0; m < 4; ++m) _Pragma("unroll") for (int n = 0; n < 2; ++n) _Pragma("unroll") for (int k = 0; k < 2; ++k) \
        acc[ai][bj][m][n] = __builtin_amdgcn_mfma_f32_16x16x32_f16(Bt[n][k], At[m][k], acc[ai][bj][m][n], 0, 0, 0); __builtin_amdgcn_s_setprio(0); } while (0)
#define PG8_WAIT_V(n) asm volatile("s_waitcnt vmcnt(" #n ")" ::: "memory")
#define PG8_WAIT_L(n) asm volatile("s_waitcnt lgkmcnt(" #n ")" ::: "memory")
#define PG8_BAR __builtin_amdgcn_s_barrier()
#define PG8_SCHED __builtin_amdgcn_sched_barrier(0)
    Unit cur, nxt; int ui = 0;
    if (!S.next(0, cur)) return;
    f32x4 acc[2][2][4][2];
#pragma unroll
    for (int a = 0; a < 2; ++a)
#pragma unroll
        for (int b = 0; b < 2; ++b)
#pragma unroll
            for (int m = 0; m < 4; ++m)
#pragma unroll
                for (int n = 0; n < 2; ++n) acc[a][b][m][n] = (f32x4){0.f, 0.f, 0.f, 0.f};
    bf16x8 At[4][2], B0[2][2], B1[2][2];
    const char* cA = (const char*)g.A + (size_t)cur.pm * tstep; const char* cB = (const char*)g.Bt + (size_t)cur.pn * tstep;
    S.a_ready(cur);
    if constexpr (SP2) {
        PG8_STAGE(PG8_SB(0, 0), cB, voffB); PG8_STAGE(PG8_SB(0, 1), cB + hstep, voffB); PG8_STAGE(PG8_SA(0, 0), cA, voffA); PG8_STAGE(PG8_SA(0, 1), cA + hstep, voffA);
        if (wr == 1) PG8_BAR;
        PG8_WAIT_V(2); PG8_BAR;
        PG8_STAGE(PG8_SB(1, 0), cB + kstep, voffB); PG8_STAGE(PG8_SA(1, 0), cA + kstep, voffA); PG8_STAGE(PG8_SB(1, 1), cB + hstep + kstep, voffB);
        PG8_WAIT_V(6); PG8_BAR;
    } else {
        PG8_STAGE(PG8_SB(0, 0), cB, voffB); PG8_STAGE(PG8_SA(0, 0), cA, voffA); PG8_STAGE(PG8_SB(0, 1), cB + hstep, voffB); PG8_STAGE(PG8_SA(0, 1), cA + hstep, voffA);
        if (wr == 1) PG8_BAR;
        PG8_WAIT_V(4); PG8_BAR;
        PG8_STAGE(PG8_SB(1, 0), cB + kstep, voffB); PG8_STAGE(PG8_SA(1, 0), cA + kstep, voffA); PG8_STAGE(PG8_SB(1, 1), cB + hstep + kstep, voffB);
        PG8_WAIT_V(6); PG8_BAR;
    }
    for (;;) {
        const bool has_next = S.next(ui + 1, nxt);
        const char* nA = has_next ? (const char*)g.A + (size_t)nxt.pm * tstep : cA; const char* nB = has_next ? (const char*)g.Bt + (size_t)nxt.pn * tstep : cB;
        for (int t = 0; t < nt; t += 2) {
            const bool last = (t == nt - 2);
            const char* a1 = cA + (size_t)(t + 1) * kstep;
            const char* a2 = last ? nA : cA + (size_t)(t + 2) * kstep; const char* b2 = last ? nB : cB + (size_t)(t + 2) * kstep;
            const char* a3 = a2 + kstep; const char* b3 = b2 + kstep;
            if (last && has_next) S.a_ready(nxt);
            if constexpr (SP2) {
            PG8_LDB(B0, 0, 0); PG8_LDB(B1, 0, 1); PG8_SCHED; PG8_LDA(At, 0, 0); PG8_STAGE(PG8_SA(1, 1), a1 + hstep, voffA);
            PG8_WAIT_V(8); PG8_WAIT_L(0); PG8_BAR; PG8_MMA(0, 0, At, B0); PG8_MMA(0, 1, At, B1); PG8_BAR; PG8_SCHED;
            PG8_LDA(At, 0, 1); PG8_STAGE(PG8_SB(0, 0), b2, voffB); PG8_STAGE(PG8_SB(0, 1), b2 + hstep, voffB); PG8_STAGE(PG8_SA(0, 0), a2, voffA);
            PG8_WAIT_V(8); PG8_WAIT_L(0); PG8_BAR; PG8_MMA(1, 0, At, B0); PG8_MMA(1, 1, At, B1); PG8_BAR; PG8_SCHED;
            PG8_LDB(B0, 1, 0); PG8_LDB(B1, 1, 1); PG8_SCHED; PG8_LDA(At, 1, 0); PG8_STAGE(PG8_SA(0, 1), a2 + hstep, voffA);
            PG8_WAIT_V(8); PG8_WAIT_L(0); PG8_BAR; PG8_MMA(0, 0, At, B0); PG8_MMA(0, 1, At, B1); PG8_BAR; PG8_SCHED;
            PG8_LDA(At, 1, 1); PG8_STAGE(PG8_SB(1, 0), b3, voffB); PG8_STAGE(PG8_SB(1, 1), b3 + hstep, voffB); PG8_STAGE(PG8_SA(1, 0), a3, voffA);
            PG8_WAIT_V(8); PG8_WAIT_L(0); PG8_BAR; PG8_MMA(1, 0, At, B0); PG8_MMA(1, 1, At, B1); PG8_BAR; PG8_SCHED;
            } else {
            PG8_LDB(B0, 0, 0); PG8_SCHED; PG8_LDA(At, 0, 0); PG8_STAGE(PG8_SA(1, 1), a1 + hstep, voffA);
            PG8_WAIT_L(8); PG8_BAR; PG8_WAIT_L(0); PG8_MMA(0, 0, At, B0); PG8_BAR; PG8_SCHED;
            PG8_LDB(B1, 0, 1); PG8_STAGE(PG8_SB(0, 0), b2, voffB);
            PG8_BAR; PG8_WAIT_L(0); PG8_MMA(0, 1, At, B1); PG8_BAR;
            PG8_LDA(At, 0, 1); PG8_STAGE(PG8_SA(0, 0), a2, voffA);
            PG8_BAR; PG8_WAIT_L(0); PG8_MMA(1, 0, At, B0); PG8_BAR; PG8_SCHED;
            PG8_STAGE(PG8_SB(0, 1), b2 + hstep, voffB);
            PG8_WAIT_V(6); PG8_BAR; PG8_MMA(1, 1, At, B1); PG8_BAR;
            PG8_LDB(B0, 1, 0); PG8_SCHED; PG8_LDA(At, 1, 0); PG8_STAGE(PG8_SA(0, 1), a2 + hstep, voffA);
            PG8_WAIT_L(8); PG8_BAR; PG8_WAIT_L(0); PG8_MMA(0, 0, At, B0); PG8_BAR; PG8_SCHED;
            PG8_LDB(B1, 1, 1); PG8_STAGE(PG8_SB(1, 0), b3, voffB);
            PG8_BAR; PG8_WAIT_L(0); PG8_MMA(0, 1, At, B1); PG8_BAR;
            PG8_LDA(At, 1, 1); PG8_STAGE(PG8_SA(1, 0), a3, voffA);
            PG8_BAR; PG8_WAIT_L(0); PG8_MMA(1, 0, At, B0); PG8_BAR; PG8_SCHED;
            PG8_STAGE(PG8_SB(1, 1), b3 + hstep, voffB);
            PG8_WAIT_V(6); PG8_BAR; PG8_MMA(1, 1, At, B1); PG8_BAR;
            }
        }
        if constexpr (ALIGN_EPI) { if (wr == 0) PG8_BAR; }
        if constexpr (!Epi::AFTER_DRAIN) { E(acc, cur, wr, wc, fr, fq); S.done(cur); }
        if (!has_next) break;
#pragma unroll
        for (int a = 0; a < 2; ++a)
#pragma unroll
            for (int b = 0; b < 2; ++b)
#pragma unroll
                for (int m = 0; m < 4; ++m)
#pragma unroll
                    for (int n = 0; n < 2; ++n) acc[a][b][m][n] = (f32x4){0.f, 0.f, 0.f, 0.f};
        cur = nxt; cA = nA; cB = nB; ++ui;
        if constexpr (ALIGN_EPI) { if (wr == 1) PG8_BAR; }
    }
    PG8_WAIT_V(0);
    if constexpr (!ALIGN_EPI) { if (wr == 0) PG8_BAR; }
    PG8_BAR;
    if constexpr (Epi::AFTER_DRAIN) { E.fused(acc, cur, wr, wc, fr, fq, lds, wid, lane); S.done(cur); }
#undef PG8_SA
#undef PG8_SB
#undef PG8_STAGE
#undef PG8_LDA
#undef PG8_LDB
#undef PG8_MMA
#undef PG8_WAIT_V
#undef PG8_WAIT_L
#undef PG8_BAR
#undef PG8_SCHED
}
}
#define LAS __attribute__((address_space(3)))
#define GAS __attribute__((address_space(1)))
typedef _Float16 h16;
typedef _Float16 h16x8 __attribute__((ext_vector_type(8)));
typedef _Float16 h16x4 __attribute__((ext_vector_type(4)));
typedef _Float16 h16x2v __attribute__((ext_vector_type(2)));
typedef float f32x2 __attribute__((ext_vector_type(2)));
typedef float f32x4 __attribute__((ext_vector_type(4)));
typedef float f32x16 __attribute__((ext_vector_type(16)));
typedef unsigned u32x4 __attribute__((ext_vector_type(4)));
typedef unsigned u32x2 __attribute__((ext_vector_type(2)));
constexpr int B_ = 8, S_ = 4096, D_ = 1024, M_ = B_ * S_, NPROJ = 2816, FF_ = 4096, NL_ = 2;
constexpr int C_Q = 0, C_K = 512, C_V = 1024, C_SCB = 1536, C_SCC = 1792, C_SCU = 2048, C_LX = 2304, C_LG = 2560;
constexpr float EPS_ = 1e-6f, QSCALE = 0.125f * 1.4426950408889634f;
constexpr size_t MiB = 1u << 20;
constexpr size_t OFF_MOD = 0, OFF_KMEAN = 384 * 1024, OFF_PB = 640 * 1024, OFF_AGG = 1 * MiB, OFF_CARRY = 3 * MiB, OFF_W = 4 * MiB;
constexpr int PB_LN1G = 0, PB_LN2G = 1024, PB_QG = 2048, PB_KG = 2112, PB_SCW = 2176, PB_LCW = 2944, PB_LCB = 3968, PB_LWA = 4224, PB_LBA = 20608,
              PB_LWX = 20864, PB_LBX = 37248, PB_LAM = 37504, PB_MIXG = 37760, PB_LAYER = 38784;
static_assert(OFF_PB + 2 * PB_LAYER * 4 <= OFF_AGG, "pb map");
constexpr size_t W_IN = 0, W_OUT = 5767168, W_UP = 7864320, W_DOWN = 16252928, W_LAYER = 24641536;
constexpr size_t OFF_XA = 52 * MiB, OFF_H = 180 * MiB, OFF_YATT = OFF_H, OFF_PCUM = OFF_H + 32 * MiB, OFF_HLOC = OFF_H + 48 * MiB;
constexpr size_t OFF_BIG = 244 * MiB, OFF_PROJ = OFF_BIG, OFF_Y = OFF_BIG + 176 * MiB, OFF_VT = OFF_Y, OFF_HID = OFF_BIG, WS_END = 500 * MiB;
constexpr size_t OFF_WF = 51 * MiB, OFF_SP = 51 * MiB + 256 * 1024;
constexpr int LDS_BYTES = 147456, LDS_BARST = 147456 - 64;
constexpr size_t OFF_BAR = 960 * 1024, BAR_BYTES = 16384;
static_assert(OFF_W + 2 * W_LAYER <= OFF_XA, "ws map");

struct Args { const float* in[21]; float* out; unsigned char* ws; };
enum { I_X = 0, I_C, I_LN1G, I_LN2G, I_WADA, I_BADA, I_WIN, I_QG, I_KG, I_SCW, I_LCW, I_LCB, I_LWA, I_LBA, I_LWX, I_LBX, I_LAM, I_MIXG, I_WOUT, I_WUP, I_WDOWN };

#define LDS_WAIT() asm volatile("s_waitcnt lgkmcnt(0)" ::: "memory")
#define WG_BAR() do { asm volatile("s_waitcnt lgkmcnt(0)" ::: "memory"); __builtin_amdgcn_s_barrier(); asm volatile("" ::: "memory"); } while (0)
__device__ __forceinline__ float wave_sum(float v) {
#pragma unroll
    for (int o = 1; o < 64; o <<= 1) v += __shfl_xor(v, o);
    return v;
}
__device__ __forceinline__ unsigned pkh(float lo, float hi) { f32x2 v = {lo, hi}; h16x2v h = __builtin_convertvector(v, h16x2v); return __builtin_bit_cast(unsigned, h); }
__device__ __forceinline__ float sigmoidf_(float x) { return 1.0f / (1.0f + __expf(-x)); }

template <bool HEADPERM> __device__ __forceinline__ void transpose_item(const float* W, int K, int N, h16* WT, LAS float* scr, int item, int lane) {
    const int nblk = N / 32, kb = item / nblk, nb = item % nblk, k0 = 64 * kb, n0 = 32 * nb;
#pragma unroll 8
    for (int i = 0; i < 32; ++i) { const int kk = 2 * i + (lane >> 5); scr[kk * 33 + (lane & 31)] = W[(size_t)(k0 + kk) * N + n0 + (lane & 31)]; }
    LDS_WAIT();
    const int c = lane & 7;
#pragma unroll
    for (int j = 0; j < 4; ++j) { const int n = (lane >> 3) + 8 * j; const LAS float* s = scr + (8 * c) * 33 + n;
        u32x4 o; o.x = pkh(s[0 * 33], s[1 * 33]); o.y = pkh(s[2 * 33], s[3 * 33]); o.z = pkh(s[4 * 33], s[5 * 33]); o.w = pkh(s[6 * 33], s[7 * 33]);
        int nr = n0 + n;
        if (HEADPERM && nr < 1024) { const int a = nr & 255; nr = (nr & ~255) + 128 * ((a >> 5) & 1) + 32 * (a >> 6) + (a & 31); }
        *(u32x4*)(WT + (size_t)nr * K + k0 + 8 * c) = o; }
    LDS_WAIT();
}
__device__ __forceinline__ void p0_phase(const Args& a, LAS unsigned char* lds, int tid, int lane, int wave) {
    unsigned char* ws = a.ws;
    LAS float* CA = (LAS float*)(lds + 69632);
    LAS float* RED = (LAS float*)(lds + 102400);
    for (int i = tid; i < B_ * D_; i += 512) { const float cv = a.in[I_C][i]; CA[i] = cv / (1.0f + __expf(-cv)); }
    __syncthreads();
    float* MOD = (float*)(ws + OFF_MOD);
    for (int it = blockIdx.x; it < 2 * 96; it += gridDim.x) {
        const int l = it / 96, cgp = it % 96, n = cgp * 64 + lane;
        const float* wp = a.in[I_WADA] + ((size_t)l * D_ + wave * 128) * 6144 + n;
        float acc[8];
#pragma unroll
        for (int b = 0; b < 8; ++b) acc[b] = 0.f;
#pragma unroll 8
        for (int kk = 0; kk < 128; ++kk) { const float wv = wp[(size_t)kk * 6144]; const int k = wave * 128 + kk;
#pragma unroll
            for (int b = 0; b < 8; ++b) acc[b] += CA[b * 1024 + k] * wv; }
#pragma unroll
        for (int b = 0; b < 8; ++b) RED[(wave * 8 + b) * 64 + lane] = acc[b];
        __syncthreads();
        { const int b = wave; float s = 0.f;
#pragma unroll
          for (int w2 = 0; w2 < 8; ++w2) s += RED[(w2 * 8 + b) * 64 + lane];
          MOD[((size_t)l * 8 + b) * 6144 + n] = s + a.in[I_BADA][l * 6144 + n]; }
        __syncthreads();
    }
    { float* PB = (float*)(ws + OFF_PB); const int gt = blockIdx.x * 512 + tid, NT = gridDim.x * 512;
#define CP(idx, off, len) for (int i = gt; i < 2 * (len); i += NT) { const int l = i / (len), r = i % (len); PB[l * PB_LAYER + (off) + r] = a.in[idx][i]; }
      CP(I_LN1G, PB_LN1G, 1024) CP(I_LN2G, PB_LN2G, 1024) CP(I_QG, PB_QG, 64) CP(I_KG, PB_KG, 64) CP(I_SCW, PB_SCW, 768) CP(I_LCW, PB_LCW, 1024) CP(I_LCB, PB_LCB, 256)
      CP(I_LWA, PB_LWA, 16384) CP(I_LBA, PB_LBA, 256) CP(I_LWX, PB_LWX, 16384) CP(I_LBX, PB_LBX, 256) CP(I_LAM, PB_LAM, 256) CP(I_MIXG, PB_MIXG, 1024)
#undef CP
    }
    { h16* WF = (h16*)(ws + OFF_WF); float* SP = (float*)(ws + OFF_SP); const int gt = blockIdx.x * 512 + tid, NT = gridDim.x * 512;
      for (int i = gt; i < 65536; i += NT) { const int e = i & 7, ln = (i >> 3) & 63, ks = (i >> 9) & 1, gate = (i >> 10) & 1, jt = (i >> 11) & 3, hh = (i >> 13) & 3, l = i >> 15;
          const int ii = 32 * ks + 8 * (ln >> 4) + e, jj = 16 * jt + (ln & 15);
          WF[i] = (h16)a.in[gate ? I_LWX : I_LWA][((size_t)(l * 4 + hh) * 64 + ii) * 64 + jj]; }
      for (int i = gt; i < 512; i += NT) SP[i] = log1pf(__expf(-a.in[I_LAM][i])); }
    LAS float* scr = (LAS float*)(lds + wave * 8448);
    const int gw = blockIdx.x * 8 + wave, NGW = gridDim.x * 8;
    constexpr int I_A = 16 * 88, I_B = 16 * 32, I_C2 = 16 * 128, I_D = 64 * 32, I_L = I_A + I_B + I_C2 + I_D;
    for (int it = gw; it < 2 * I_L; it += NGW) {
        const int l = it / I_L; int r = it % I_L;
        unsigned char* wl = ws + OFF_W + (size_t)l * W_LAYER;
        if (r < I_A) { transpose_item<true>(a.in[I_WIN] + (size_t)l * D_ * NPROJ, D_, NPROJ, (h16*)(wl + W_IN), scr, r, lane); continue; } r -= I_A;
        if (r < I_B) { transpose_item<false>(a.in[I_WOUT] + (size_t)l * D_ * D_, D_, D_, (h16*)(wl + W_OUT), scr, r, lane); continue; } r -= I_B;
        if (r < I_C2) { transpose_item<false>(a.in[I_WUP] + (size_t)l * D_ * FF_, D_, FF_, (h16*)(wl + W_UP), scr, r, lane); continue; } r -= I_C2;
        transpose_item<false>(a.in[I_WDOWN] + (size_t)l * FF_ * D_, FF_, D_, (h16*)(wl + W_DOWN), scr, r, lane);
    }
}

template <bool XH16> __device__ __forceinline__ void ln_phase(const void* xv_, const float* g, const float* modl, int shift_chunk, int scale_chunk, h16* H, int gw, int NGW, int lane) {
    for (int row0 = gw * 4; row0 < M_; row0 += NGW * 4) {
        const int b = row0 >> 12;
        const float* mb = modl + (size_t)b * 6144;
        f32x4 v[4][4]; float ss[4];
#pragma unroll
        for (int r = 0; r < 4; ++r) {
            if (XH16) { const h16x4* xr = (const h16x4*)((const h16*)xv_ + (size_t)(row0 + r) * D_) + lane;
#pragma unroll
                for (int j = 0; j < 4; ++j) { const h16x4 hv = xr[64 * j];
                    v[r][j] = (f32x4){(float)hv[0], (float)hv[1], (float)hv[2], (float)hv[3]}; } }
            else { const f32x4* xr = (const f32x4*)((const float*)xv_ + (size_t)(row0 + r) * D_) + lane;
#pragma unroll
                for (int j = 0; j < 4; ++j) v[r][j] = xr[64 * j]; } }
        f32x4 cs[4], sh[4];
#pragma unroll
        for (int j = 0; j < 4; ++j) { const int col = 256 * j + 4 * lane;
            cs[j] = *(const f32x4*)(g + col) * (*(const f32x4*)(mb + scale_chunk * 1024 + col) + 1.0f); sh[j] = *(const f32x4*)(mb + shift_chunk * 1024 + col); }
#pragma unroll
        for (int r = 0; r < 4; ++r) { float s = 0.f;
#pragma unroll
            for (int j = 0; j < 4; ++j) s += (v[r][j].x * v[r][j].x + v[r][j].y * v[r][j].y) + (v[r][j].z * v[r][j].z + v[r][j].w * v[r][j].w);
            ss[r] = s; }
#pragma unroll
        for (int o = 1; o < 64; o <<= 1) {
#pragma unroll
            for (int r = 0; r < 4; ++r) ss[r] += __shfl_xor(ss[r], o); }
#pragma unroll
        for (int r = 0; r < 4; ++r) { const float rr = rsqrtf(ss[r] * (1.0f / D_) + EPS_);
#pragma unroll
            for (int j = 0; j < 4; ++j) { const int col = 256 * j + 4 * lane; const f32x4 y = v[r][j] * rr * cs[j] + sh[j];
                u32x2 o; o.x = pkh(y.x, y.y); o.y = pkh(y.z, y.w);
                *(u32x2*)(H + (size_t)(row0 + r) * D_ + col) = o; } }
    }
}

__device__ __forceinline__ void lru_phase(unsigned char* ws, int l, LAS unsigned char* lds, int lane, int wave) {
    const float* PB = (const float*)(ws + OFF_PB) + (size_t)l * PB_LAYER;
    const h16* WF = (const h16*)(ws + OFF_WF) + (size_t)l * 32768; const float* SP = (const float*)(ws + OFF_SP) + l * 256;
    const h16* PROJ = (const h16*)(ws + OFF_PROJ);
    h16* HLOC = (h16*)(ws + OFF_HLOC); h16* PCUM = (h16*)(ws + OFF_PCUM); float* AGG = (float*)(ws + OFF_AGG);
    LAS h16* XH = (LAS h16*)(lds + wave * 17408);
    LAS float* XF = (LAS float*)(lds + wave * 17408 + 4608);
    LAS h16* OP = (LAS h16*)(lds + wave * 17408 + 12800);
    { float* KMEAN = (float*)(ws + OFF_KMEAN); const int c8 = lane & 7, r8 = lane >> 3;
      for (int wi = blockIdx.x * 8 + wave; wi < B_ * 8 * 16; wi += gridDim.x * 8) {
          const int b = wi >> 7, n = (wi >> 3) & 15, h = wi & 7;
          const h16* base = PROJ + ((size_t)b * S_ + n * 256 + r8) * NPROJ + C_K + h * 64 + 8 * c8;
          float ks[8];
#pragma unroll
          for (int j = 0; j < 8; ++j) ks[j] = 0.f;
#pragma unroll 8
          for (int i = 0; i < 32; ++i) { const h16x8 v = *(const h16x8*)(base + (size_t)(8 * i) * NPROJ);
#pragma unroll
              for (int j = 0; j < 8; ++j) ks[j] += (float)v[j]; }
#pragma unroll
          for (int j = 0; j < 8; ++j) { float s = ks[j]; s += __shfl_xor(s, 8); s += __shfl_xor(s, 16); s += __shfl_xor(s, 32); ks[j] = s * (1.0f / 256.0f); }
          if (lane < 8) { float* kp = KMEAN + ((size_t)(b * 8 + h) * 16 + n) * 64 + 8 * lane; *(f32x4*)kp = (f32x4){ks[0], ks[1], ks[2], ks[3]}; *(f32x4*)(kp + 4) = (f32x4){ks[4], ks[5], ks[6], ks[7]}; } } }
    const int j16 = lane & 15, q4 = lane >> 4;
    for (int wi = blockIdx.x * 8 + wave; wi < B_ * 128 * 4; wi += gridDim.x * 8) {
        const int b = wi >> 9, chn = (wi >> 2) & 127, hh = wi & 3, t0 = chn * 32;
        { const int cj = hh * 64 + lane;
          const float* cwp = PB + PB_LCW + cj;
          const float cw0 = cwp[0], cw1 = cwp[256], cw2 = cwp[512], cw3 = cwp[768], cb = PB[PB_LCB + cj];
          const h16* lx = PROJ + ((size_t)b * S_ + t0) * NPROJ + C_LX + cj;
          h16 xin[35];
#pragma unroll
          for (int t = 0; t < 3; ++t) xin[t] = (t0 > 0) ? lx[(t - 3) * NPROJ] : (h16)0.f;
#pragma unroll
          for (int t = 0; t < 32; ++t) xin[3 + t] = lx[(size_t)t * NPROJ];
#pragma unroll
          for (int t = 0; t < 32; ++t) { const float xr = cw0 * (float)xin[t] + cw1 * (float)xin[t + 1] + cw2 * (float)xin[t + 2] + cw3 * (float)xin[t + 3] + cb;
              XF[t * 64 + lane] = xr; XH[t * 72 + lane] = (h16)xr; } }
        LDS_WAIT();
        h16x8 afr[2][2];
#pragma unroll
        for (int tt = 0; tt < 2; ++tt)
#pragma unroll
            for (int ks = 0; ks < 2; ++ks) afr[tt][ks] = *(const LAS h16x8*)(XH + (16 * tt + j16) * 72 + 32 * ks + 8 * q4);
        LDS_WAIT();
        const size_t tokb = (size_t)b * S_ + t0;
#pragma unroll 1
        for (int jt = 0; jt < 4; ++jt) {
            const int j = 16 * jt + j16, cj = hh * 64 + j;
            const h16* wfp = WF + (size_t)((hh * 4 + jt) * 4) * 512 + lane * 8;
            const h16x8 wfa0 = *(const h16x8*)(wfp), wfa1 = *(const h16x8*)(wfp + 512), wfx0 = *(const h16x8*)(wfp + 1024), wfx1 = *(const h16x8*)(wfp + 1536);
            f32x4 pa[2], px[2];
#pragma unroll
            for (int tt = 0; tt < 2; ++tt) { pa[tt] = (f32x4){0.f, 0.f, 0.f, 0.f}; px[tt] = (f32x4){0.f, 0.f, 0.f, 0.f};
                pa[tt] = __builtin_amdgcn_mfma_f32_16x16x32_f16(afr[tt][0], wfa0, pa[tt], 0, 0, 0); pa[tt] = __builtin_amdgcn_mfma_f32_16x16x32_f16(afr[tt][1], wfa1, pa[tt], 0, 0, 0);
                px[tt] = __builtin_amdgcn_mfma_f32_16x16x32_f16(afr[tt][0], wfx0, px[tt], 0, 0, 0); px[tt] = __builtin_amdgcn_mfma_f32_16x16x32_f16(afr[tt][1], wfx1, px[tt], 0, 0, 0); }
            const float ba = PB[PB_LBA + cj], bx = PB[PB_LBX + cj], sp = SP[cj];
            float cA = 1.f, cH = 0.f;
#pragma unroll
            for (int tt = 0; tt < 2; ++tt) {
                float av[4], hv[4]; float hr = 0.f, pr_ = 1.f;
#pragma unroll
                for (int r = 0; r < 4; ++r) { const int t = 16 * tt + 4 * q4 + r; const float xv = XF[t * 64 + j];
                    const float rg = __builtin_amdgcn_rcpf(1.0f + __expf(-(pa[tt][r] + ba))), ig = __builtin_amdgcn_rcpf(1.0f + __expf(-(px[tt][r] + bx)));
                    const float la = -8.0f * rg * sp, aa = __expf(la);
                    const float u = sqrtf(fmaxf(1.0f - aa * aa, 0.f)) * (ig * xv);
                    hr = aa * hr + u; pr_ *= aa; hv[r] = hr; av[r] = pr_; }
                float Ai = pr_, Hi = hr;
                { const float Ap = __shfl_up(Ai, 16), Hp = __shfl_up(Hi, 16); if (q4 >= 1) { Hi = Ai * Hp + Hi; Ai = Ai * Ap; } }
                { const float Ap = __shfl_up(Ai, 32), Hp = __shfl_up(Hi, 32); if (q4 >= 2) { Hi = Ai * Hp + Hi; Ai = Ai * Ap; } }
                float Ae = __shfl_up(Ai, 16), He = __shfl_up(Hi, 16); if (q4 == 0) { Ae = 1.f; He = 0.f; }
                const float Hin = Ae * cH + He, Ain = Ae * cA;
#pragma unroll
                for (int r = 0; r < 4; ++r) { const int t = 16 * tt + 4 * q4 + r; XH[t * 72 + j] = (h16)(hv[r] + av[r] * Hin); OP[t * 72 + j] = (h16)(av[r] * Ain); }
                const float At = __shfl(Ai, 48 + j16), Ht = __shfl(Hi, 48 + j16);
                cH = At * cH + Ht; cA = At * cA;
            }
            if (q4 == 0) { float* ag = AGG + (((size_t)b * 128 + chn) * 256 + cj) * 2; *(f32x2*)ag = (f32x2){cA, cH}; }
        }
        LDS_WAIT();
#pragma unroll
        for (int k = 0; k < 4; ++k) { const int id2 = k * 64 + lane, t = id2 >> 3, c8 = id2 & 7; const size_t o = (tokb + t) * 256 + hh * 64 + 8 * c8;
            *(u32x4*)(HLOC + o) = *(const LAS u32x4*)(XH + t * 72 + 8 * c8); *(u32x4*)(PCUM + o) = *(const LAS u32x4*)(OP + t * 72 + 8 * c8); }
        LDS_WAIT();
    }
}

typedef short s16x4v __attribute__((ext_vector_type(4)));
__device__ __forceinline__ h16x4 vtr4(const LAS h16* p) { return __builtin_bit_cast(h16x4, __builtin_amdgcn_ds_read_tr16_b64_v4i16((LAS s16x4v*)p)); }
constexpr int AT_KP = 72, AT_VP = 96;
constexpr int AT_KB = 128 * AT_KP, AT_VB = 128 * AT_VP;
template <bool OWN>
__device__ __forceinline__ void attn_tile(const LAS h16* Kt0, const LAS h16* Vt0, const h16x8 (&qf)[4], f32x16& o0, f32x16& o1, float& m_run, float& l_run,
                                          bool lsel, int kt, int w, int r32, int hi, int sig, int vbase) {
    f32x16 sa[2][2];
    if (!OWN) {
#pragma unroll
        for (int st = 0; st < 2; ++st) {
            const LAS h16* Kt = Kt0 + 64 * st * AT_KP;
            h16x8 kf[2][4];
#pragma unroll
            for (int sh = 0; sh < 2; ++sh)
#pragma unroll
                for (int ks = 0; ks < 4; ++ks) kf[sh][ks] = *(const LAS h16x8*)(Kt + (32 * sh + sig) * AT_KP + 16 * ks + 8 * hi);
#pragma unroll
            for (int i = 0; i < 16; ++i) { sa[st][0][i] = 0.f; sa[st][1][i] = 0.f; }
#pragma unroll
            for (int ks = 0; ks < 4; ++ks) { sa[st][0] = __builtin_amdgcn_mfma_f32_32x32x16_f16(kf[0][ks], qf[ks], sa[st][0], 0, 0, 0);
                                             sa[st][1] = __builtin_amdgcn_mfma_f32_32x32x16_f16(kf[1][ks], qf[ks], sa[st][1], 0, 0, 0); }
        }
    }
    if (!OWN) {
        float mx = fmaxf(fmaxf(sa[0][0][0], sa[0][1][0]), fmaxf(sa[1][0][0], sa[1][1][0]));
#pragma unroll
        for (int i = 1; i < 16; ++i) mx = fmaxf(mx, fmaxf(fmaxf(sa[0][0][i], sa[0][1][i]), fmaxf(sa[1][0][i], sa[1][1][i])));
        mx = fmaxf(mx, __shfl_xor(mx, 32));
        mx = lsel ? mx : -INFINITY;
        if (__any(mx > m_run + 8.0f)) {
            const float m_new = (mx > m_run + 8.0f) ? mx : m_run;
            const float alpha = __builtin_amdgcn_exp2f(m_run - m_new);
            m_run = m_new; l_run *= alpha;
#pragma unroll
            for (int i = 0; i < 16; ++i) { o0[i] *= alpha; o1[i] *= alpha; }
        }
        const float m_eff = lsel ? m_run : INFINITY;
        float ps = 0.f;
#pragma unroll
        for (int st = 0; st < 2; ++st)
#pragma unroll
            for (int sh = 0; sh < 2; ++sh) {
#pragma unroll
                for (int i = 0; i < 16; ++i) { sa[st][sh][i] = __builtin_amdgcn_exp2f(sa[st][sh][i] - m_eff); ps += sa[st][sh][i]; }
#pragma unroll
                for (int s2 = 0; s2 < 2; ++s2) {
                    h16x8 pf;
#pragma unroll
                    for (int j = 0; j < 8; ++j) pf[j] = (h16)sa[st][sh][8 * s2 + j];
                    const LAS h16* vp = Vt0 + vbase + (64 * st + 32 * sh + 16 * s2) * AT_VP;
                    const h16x8 v0 = __builtin_shufflevector(vtr4(vp), vtr4(vp + 4 * AT_VP), 0, 1, 2, 3, 4, 5, 6, 7);
                    const h16x8 v1 = __builtin_shufflevector(vtr4(vp + 32), vtr4(vp + 4 * AT_VP + 32), 0, 1, 2, 3, 4, 5, 6, 7);
                    o0 = __builtin_amdgcn_mfma_f32_32x32x16_f16(v0, pf, o0, 0, 0, 0);
                    o1 = __builtin_amdgcn_mfma_f32_32x32x16_f16(v1, pf, o1, 0, 0, 0); } }
        l_run += ps;
        return;
    }
#pragma unroll
    for (int st = 0; st < 2; ++st) {
        const int j16 = kt * 2 + st;
        if (OWN && 2 * j16 > w) continue;
        const LAS h16* Kt = Kt0 + 64 * st * AT_KP; const LAS h16* Vt = Vt0 + 64 * st * AT_VP + vbase;
        f32x16 s0, s1;
        if (OWN) {
            h16x8 kf[2][4];
#pragma unroll
            for (int sh = 0; sh < 2; ++sh)
#pragma unroll
                for (int ks = 0; ks < 4; ++ks) kf[sh][ks] = *(const LAS h16x8*)(Kt + (32 * sh + sig) * AT_KP + 16 * ks + 8 * hi);
#pragma unroll
            for (int i = 0; i < 16; ++i) { s0[i] = 0.f; s1[i] = 0.f; }
#pragma unroll
            for (int ks = 0; ks < 4; ++ks) { s0 = __builtin_amdgcn_mfma_f32_32x32x16_f16(kf[0][ks], qf[ks], s0, 0, 0, 0);
                                             s1 = __builtin_amdgcn_mfma_f32_32x32x16_f16(kf[1][ks], qf[ks], s1, 0, 0, 0); }
        } else { s0 = sa[st][0]; s1 = sa[st][1]; }
        if (OWN) {
            const int rel0 = 2 * j16 - w;
            if (rel0 == 0) {
#pragma unroll
                for (int i = 0; i < 16; ++i) { const int key = (i & 3) + 4 * ((i >> 2) & 1) + 8 * hi + 16 * (i >> 3); s0[i] = key <= r32 ? s0[i] : -INFINITY; } }
            if (rel0 + 1 > 0) {
#pragma unroll
                for (int i = 0; i < 16; ++i) s1[i] = -INFINITY; }
            else if (rel0 + 1 == 0) {
#pragma unroll
                for (int i = 0; i < 16; ++i) { const int key = (i & 3) + 4 * ((i >> 2) & 1) + 8 * hi + 16 * (i >> 3); s1[i] = key <= r32 ? s1[i] : -INFINITY; } }
        }
        float mx = fmaxf(s0[0], s1[0]);
#pragma unroll
        for (int i = 1; i < 16; ++i) mx = fmaxf(mx, fmaxf(s0[i], s1[i]));
        mx = fmaxf(mx, __shfl_xor(mx, 32));
        if (!OWN) mx = lsel ? mx : -INFINITY;
        if (__any(mx > m_run + 8.0f)) {
            const float m_new = (mx > m_run + 8.0f) ? mx : m_run;
            const float alpha = __builtin_amdgcn_exp2f(m_run - m_new);
            m_run = m_new; l_run *= alpha;
#pragma unroll
            for (int i = 0; i < 16; ++i) { o0[i] *= alpha; o1[i] *= alpha; }
        }
        const float m_eff = (OWN || lsel) ? m_run : INFINITY;
        float ps = 0.f;
#pragma unroll
        for (int i = 0; i < 16; ++i) { s0[i] = __builtin_amdgcn_exp2f(s0[i] - m_eff); s1[i] = __builtin_amdgcn_exp2f(s1[i] - m_eff); ps += s0[i] + s1[i]; }
        l_run += ps;
        h16x8 pf[2][2];
#pragma unroll
        for (int s2 = 0; s2 < 2; ++s2)
#pragma unroll
            for (int j = 0; j < 8; ++j) { pf[0][s2][j] = (h16)s0[8 * s2 + j]; pf[1][s2][j] = (h16)s1[8 * s2 + j]; }
#pragma unroll
        for (int sh = 0; sh < 2; ++sh)
#pragma unroll
            for (int s2 = 0; s2 < 2; ++s2) {
                const LAS h16* vp = Vt + (32 * sh + 16 * s2) * AT_VP;
                const h16x8 v0 = __builtin_shufflevector(vtr4(vp), vtr4(vp + 4 * AT_VP), 0, 1, 2, 3, 4, 5, 6, 7);
                const h16x8 v1 = __builtin_shufflevector(vtr4(vp + 32), vtr4(vp + 4 * AT_VP + 32), 0, 1, 2, 3, 4, 5, 6, 7);
                o0 = __builtin_amdgcn_mfma_f32_32x32x16_f16(v0, pf[sh][s2], o0, 0, 0, 0);
                o1 = __builtin_amdgcn_mfma_f32_32x32x16_f16(v1, pf[sh][s2], o1, 0, 0, 0); }
    }
}
__device__ __forceinline__ void attn_phase(unsigned char* ws, LAS unsigned char* lds, int tid, int lane, int w) {
    const h16* PROJ = (const h16*)(ws + OFF_PROJ); const float* KMEAN = (const float*)(ws + OFF_KMEAN);
    h16* YATT = (h16*)(ws + OFF_YATT);
    { const float* AGG = (const float*)(ws + OFF_AGG); float* CARRY = (float*)(ws + OFF_CARRY);
      for (int sc = blockIdx.x * 8 + w; sc < B_ * 256; sc += gridDim.x * 8) {
          const int b = sc >> 8, cj = sc & 255;
          const size_t o0 = ((size_t)b * 128 + 2 * lane) * 256 + cj, o1 = o0 + 256;
          const f32x2 g0 = *(const f32x2*)(AGG + o0 * 2), g1 = *(const f32x2*)(AGG + o1 * 2);
          float A = g0.x * g1.x, H = g1.x * g0.y + g1.y;
#pragma unroll
          for (int d = 1; d < 64; d <<= 1) { const float Ap = __shfl_up(A, d), Hp = __shfl_up(H, d); if (lane >= d) { H = A * Hp + H; A = A * Ap; } }
          float He = __shfl_up(H, 1); if (lane == 0) He = 0.f;
          CARRY[o0] = He; CARRY[o1] = g0.x * He + g0.y; } }
    const int r32 = lane & 31, hi = lane >> 5;
    LAS h16* Kb = (LAS h16*)lds; LAS h16* Vb = (LAS h16*)(lds + 2 * AT_KB * 2); LAS float* KM = (LAS float*)(lds + 2 * AT_KB * 2 + 2 * AT_VB * 2);
    const int srow = tid >> 3, sch = tid & 7;
    const int sig = (r32 & 19) | ((r32 & 4) << 1) | ((r32 & 8) >> 1);
    const int vbase = (8 * hi + ((lane & 15) >> 2)) * AT_VP + 16 * ((lane >> 4) & 1) + 4 * (lane & 3);
    for (int it = blockIdx.x; it < 1024; it += gridDim.x) {
        int own, bh;
        if (gridDim.x == 256) { const int rnd = it >> 8, xcd = it & 7, i5 = (it >> 3) & 31; bh = xcd * 8 + 2 * rnd + (i5 >> 4); own = (rnd & 1) ? (i5 & 15) : 15 - (i5 & 15); }
        else { const int rnd = it >> 8, c = it & 255, g = c >> 6; bh = c & 63; own = rnd == 0 ? 15 - g : rnd == 1 ? 8 + g : rnd == 2 ? 7 - g : g; }
        const int b = bh >> 3, h = bh & 7;
        __syncthreads();
        { const f32x2 kv = *(const f32x2*)(KMEAN + (size_t)bh * 1024 + 2 * tid); KM[2 * tid] = kv.x; KM[2 * tid + 1] = kv.y; }
        const size_t tokq = (size_t)b * S_ + own * 256 + 32 * w + r32;
        const h16* qrow = PROJ + tokq * NPROJ + C_Q + h * 64 + 8 * hi;
        h16x8 qf[4];
#pragma unroll
        for (int ks = 0; ks < 4; ++ks) qf[ks] = *(const h16x8*)(qrow + 16 * ks);
        const h16* kg = PROJ + ((size_t)b * S_ + srow) * NPROJ + C_K + h * 64 + sch * 8;
        const int T = 2 * (own + 1);
#define AT_TOK(ti) (((ti) < 2 ? own : (((ti) - 2) >> 1)) * 256 + ((ti) & 1) * 128)
#define AT_LOAD(R, ti) do { const h16* p_ = kg + (size_t)AT_TOK(ti) * NPROJ; R[0] = *(const u32x4*)p_; R[1] = *(const u32x4*)(p_ + (size_t)64 * NPROJ); \
        R[2] = *(const u32x4*)(p_ + (C_V - C_K)); R[3] = *(const u32x4*)(p_ + (size_t)64 * NPROJ + (C_V - C_K)); } while (0)
#define AT_STORE(R, buf) do { LAS h16* kd_ = Kb + (buf) * AT_KB + srow * AT_KP + sch * 8; LAS h16* vd_ = Vb + (buf) * AT_VB + srow * AT_VP + sch * 8; \
        *(LAS u32x4*)kd_ = R[0]; *(LAS u32x4*)(kd_ + 64 * AT_KP) = R[1]; *(LAS u32x4*)vd_ = R[2]; *(LAS u32x4*)(vd_ + 64 * AT_VP) = R[3]; } while (0)
        u32x4 R[4];
        AT_LOAD(R, 0);
        __syncthreads();
        unsigned sel = 0;
        {
            float b0 = -INFINITY, b1 = -INFINITY, b2 = -INFINITY; int i0 = -1, i1 = -1, i2 = -1;
#pragma unroll 1
            for (int n = 0; n < own; ++n) {
                float sc = 0.f;
#pragma unroll
                for (int ks = 0; ks < 4; ++ks)
#pragma unroll
                    for (int jj = 0; jj < 2; ++jj) { const f32x4 kmv = *(const LAS f32x4*)(KM + n * 64 + 16 * ks + 8 * hi + 4 * jj);
                        sc += (float)qf[ks][4 * jj + 0] * kmv.x + (float)qf[ks][4 * jj + 1] * kmv.y + (float)qf[ks][4 * jj + 2] * kmv.z + (float)qf[ks][4 * jj + 3] * kmv.w; }
                sc += __shfl_xor(sc, 32);
                const bool g0 = sc > b0, g1 = sc > b1, g2 = sc > b2;
                b2 = g1 ? b1 : (g2 ? sc : b2); i2 = g1 ? i1 : (g2 ? n : i2);
                b1 = g0 ? b0 : (g1 ? sc : b1); i1 = g0 ? i0 : (g1 ? n : i1);
                b0 = g0 ? sc : b0;             i0 = g0 ? n : i0;
            }
            if (i0 >= 0) sel |= 1u << i0;
            if (i1 >= 0) sel |= 1u << i1;
            if (i2 >= 0) sel |= 1u << i2;
        }
        AT_STORE(R, 0);
        AT_LOAD(R, 1);
        __syncthreads();
        float m_run = -INFINITY, l_run = 0.f;
        f32x16 o0, o1;
#pragma unroll
        for (int i = 0; i < 16; ++i) { o0[i] = 0.f; o1[i] = 0.f; }
        for (int ti = 0; ti < T; ++ti) {
            const int buf = ti & 1;
            AT_STORE(R, buf ^ 1);
            { const int tn = (ti + 2 < T) ? ti + 2 : T - 1; AT_LOAD(R, tn); }
            const int blk = ti < 2 ? own : (ti - 2) >> 1; const bool isown = (blk == own), lsel = isown || ((sel >> blk) & 1u);
            if (isown) attn_tile<true>(Kb + buf * AT_KB, Vb + buf * AT_VB, qf, o0, o1, m_run, l_run, true, ti & 1, w, r32, hi, sig, vbase);
            else if (__ballot(lsel) != 0ull) attn_tile<false>(Kb + buf * AT_KB, Vb + buf * AT_VB, qf, o0, o1, m_run, l_run, lsel, ti & 1, w, r32, hi, sig, vbase);
            WG_BAR();
        }
#undef AT_TOK
#undef AT_LOAD
#undef AT_STORE
        l_run += __shfl_xor(l_run, 32);
        const float inv = 1.0f / l_run;
        h16* orow = YATT + tokq * 512 + h * 64 + 4 * hi;
#pragma unroll
        for (int q = 0; q < 4; ++q) {
            u32x2 w0; w0.x = pkh(o0[4 * q] * inv, o0[4 * q + 1] * inv); w0.y = pkh(o0[4 * q + 2] * inv, o0[4 * q + 3] * inv);
            u32x2 w1; w1.x = pkh(o1[4 * q] * inv, o1[4 * q + 1] * inv); w1.y = pkh(o1[4 * q + 2] * inv, o1[4 * q + 3] * inv);
            *(u32x2*)(orow + 8 * q) = w0; *(u32x2*)(orow + 32 + 8 * q) = w1; }
    }
}

__device__ __forceinline__ float gelu_tanh(float x) { const float z = 0.7978845608028654f * (x + 0.044715f * x * x * x); const float t = 1.0f - 2.0f / (__expf(2.0f * z) + 1.0f); return 0.5f * x * (1.0f + t); }
__device__ __forceinline__ void mixnorm_phase(unsigned char* ws, int l, int gw, int NGW, int lane) {
    const float* PB = (const float*)(ws + OFF_PB) + (size_t)l * PB_LAYER;
    const h16* PROJ = (const h16*)(ws + OFF_PROJ); const h16* YATT = (const h16*)(ws + OFF_YATT);
    const h16* HLOC = (const h16*)(ws + OFF_HLOC); const h16* PCUM = (const h16*)(ws + OFF_PCUM); const float* CARRY = (const float*)(ws + OFF_CARRY);
    h16* Y = (h16*)(ws + OFF_Y);
    const float* mg = PB + PB_MIXG; const float* scw = PB + PB_SCW;
    for (int tok0 = gw * 2; tok0 < M_; tok0 += NGW * 2) {
        float fa[2][8], yc[2][4], yl[2][4], ssa[2], ssc[2], ssl[2];
#pragma unroll
        for (int u = 0; u < 2; ++u) {
            const int tok = tok0 + u; const int b = tok >> 12, t = tok & 4095, chn = t >> 5;
            const h16x8 ya = *(const h16x8*)(YATT + (size_t)tok * 512 + 8 * lane);
            float sa_ = 0.f;
#pragma unroll
            for (int j = 0; j < 8; ++j) { fa[u][j] = (float)ya[j]; sa_ += fa[u][j] * fa[u][j]; }
            ssa[u] = sa_;
            const h16* pr = PROJ + (size_t)tok * NPROJ;
            const h16x4 bb = *(const h16x4*)(pr + C_SCB + 4 * lane);
            f32x4 conv = {0.f, 0.f, 0.f, 0.f};
#pragma unroll
            for (int k = 0; k < 3; ++k) { if (t - 2 + k >= 0) { const h16* pk = pr + (k - 2) * NPROJ;
                const h16x4 cc = *(const h16x4*)(pk + C_SCC + 4 * lane), uu = *(const h16x4*)(pk + C_SCU + 4 * lane);
                const f32x4 wv = *(const f32x4*)(scw + k * 256 + 4 * lane);
#pragma unroll
                for (int j = 0; j < 4; ++j) conv[j] += wv[j] * ((float)cc[j] * (float)uu[j]); } }
            float sc_ = 0.f;
#pragma unroll
            for (int j = 0; j < 4; ++j) { yc[u][j] = (float)bb[j] * conv[j]; sc_ += yc[u][j] * yc[u][j]; }
            ssc[u] = sc_;
            const h16x4 hl = *(const h16x4*)(HLOC + (size_t)tok * 256 + 4 * lane), pc = *(const h16x4*)(PCUM + (size_t)tok * 256 + 4 * lane);
            const f32x4 cr = *(const f32x4*)(CARRY + ((size_t)b * 128 + chn) * 256 + 4 * lane);
            const h16x4 lg = *(const h16x4*)(pr + C_LG + 4 * lane);
            float sl_ = 0.f;
#pragma unroll
            for (int j = 0; j < 4; ++j) { const float hv = (float)hl[j] + (float)pc[j] * cr[j]; yl[u][j] = hv * gelu_tanh((float)lg[j]); sl_ += yl[u][j] * yl[u][j]; }
            ssl[u] = sl_;
        }
#pragma unroll
        for (int o = 1; o < 64; o <<= 1) {
#pragma unroll
            for (int u = 0; u < 2; ++u) { ssa[u] += __shfl_xor(ssa[u], o); ssc[u] += __shfl_xor(ssc[u], o); ssl[u] += __shfl_xor(ssl[u], o); } }
        const f32x4 ga0 = *(const f32x4*)(mg + 8 * lane), ga1 = *(const f32x4*)(mg + 8 * lane + 4), gc = *(const f32x4*)(mg + 512 + 4 * lane), gl = *(const f32x4*)(mg + 768 + 4 * lane);
#pragma unroll
        for (int u = 0; u < 2; ++u) {
            const float ra = rsqrtf(ssa[u] * (1.0f / 512.0f) + EPS_), rc = rsqrtf(ssc[u] * (1.0f / 256.0f) + EPS_), rl = rsqrtf(ssl[u] * (1.0f / 256.0f) + EPS_);
            h16* yo = Y + (size_t)(tok0 + u) * 1024;
            { u32x4 o; o.x = pkh(fa[u][0] * ra * ga0.x, fa[u][1] * ra * ga0.y); o.y = pkh(fa[u][2] * ra * ga0.z, fa[u][3] * ra * ga0.w);
              o.z = pkh(fa[u][4] * ra * ga1.x, fa[u][5] * ra * ga1.y); o.w = pkh(fa[u][6] * ra * ga1.z, fa[u][7] * ra * ga1.w);
              *(u32x4*)(yo + 8 * lane) = o; }
            { u32x2 o; o.x = pkh(yc[u][0] * rc * gc.x, yc[u][1] * rc * gc.y); o.y = pkh(yc[u][2] * rc * gc.z, yc[u][3] * rc * gc.w);
              *(u32x2*)(yo + 512 + 4 * lane) = o; }
            { u32x2 o; o.x = pkh(yl[u][0] * rl * gl.x, yl[u][1] * rl * gl.y); o.y = pkh(yl[u][2] * rl * gl.z, yl[u][3] * rl * gl.w);
              *(u32x2*)(yo + 768 + 4 * lane) = o; }
        }
    }
}

#define XB_TMO      128
#define XB_XCNT(j)  (256  + 64 * (j))
#define XB_XSUB(j)  (1280 + 64 * (j))
#define XB_XGEN(j)  (2304 + 64 * (j))
#define XB_TOP      3328
#define XB_TOPGEN   3392
#define XCD_BAR_WORDS 3456
#define XB_SPIN_CAP (1u << 18)

__device__ __forceinline__ unsigned xb_ld(unsigned* p)              { return __hip_atomic_load(p, __ATOMIC_RELAXED, __HIP_MEMORY_SCOPE_AGENT); }
__device__ __forceinline__ unsigned xb_add(unsigned* p, unsigned v) { return __hip_atomic_fetch_add(p, v, __ATOMIC_RELAXED, __HIP_MEMORY_SCOPE_AGENT); }
__device__ __forceinline__ unsigned xb_xcc_id() { return (unsigned)__builtin_amdgcn_s_getreg((3 << 11) | 20) & 0xFu; }
#define XB_SPIN(cond, bar) do { unsigned _sp = 0; while (cond) { __builtin_amdgcn_s_sleep(1); \
    if ((++_sp & 255u) == 0u) { if (xb_ld(&(bar)[XB_TMO])) break; if (_sp > XB_SPIN_CAP) { atomicAdd(&(bar)[XB_TMO], 1u); break; } } } } while (0)

struct XcdBarrier {
    unsigned* bar; unsigned x;
    volatile LAS unsigned* st;
};

__device__ __forceinline__ XcdBarrier xcd_barrier_post(unsigned* bar, volatile LAS unsigned* st) {
    XcdBarrier b; b.bar = bar; b.x = xb_xcc_id(); b.st = st;
    if (threadIdx.x == 0) (void)xb_add(&bar[XB_XCNT(b.x)], 1u);
    return b;
}
__device__ __forceinline__ void xcd_barrier_complete(unsigned* bar, unsigned x, unsigned& nloc, unsigned& nx) {
    const unsigned G = gridDim.x * gridDim.y * gridDim.z;
    unsigned sum, cnt, mine, sp = 0u;
    for (;;) {
        sum = 0u; cnt = 0u; mine = 0u;
#pragma unroll
        for (unsigned j = 0; j < 16; ++j) { const unsigned c = xb_ld(&bar[XB_XCNT(j)]); sum += c; cnt += (c > 0u) ? 1u : 0u; mine = (j == x) ? c : mine; }
        if (sum == G) break;
        __builtin_amdgcn_s_sleep(1);
        if ((++sp & 255u) == 0u) { if (xb_ld(&bar[XB_TMO])) break; if (sp > XB_SPIN_CAP) { atomicAdd(&bar[XB_TMO], 1u); break; } }
    }
    nloc = mine > 0u ? mine : 1u; nx = cnt > 0u ? cnt : 1u;
}

__device__ __forceinline__ void xcd_barrier(const XcdBarrier& b) {
    asm volatile("s_waitcnt vmcnt(0)" ::: "memory");
    __syncthreads();
    if (threadIdx.x == 0) {
        unsigned* bar = b.bar;
        __builtin_amdgcn_s_waitcnt(0);
        unsigned nloc = b.st[0], nx = b.st[1];
        if (nloc == 0u) { xcd_barrier_complete(bar, b.x, nloc, nx); b.st[0] = nloc; b.st[1] = nx; }
        const unsigned old = xb_add(&bar[XB_XSUB(b.x)], 1u);
        const unsigned gen = old / nloc;
        if (old + 1u == (gen + 1u) * nloc) {
            __builtin_amdgcn_fence(__ATOMIC_RELEASE, "agent");
            asm volatile("s_waitcnt vmcnt(0)" ::: "memory");
            const unsigned og = xb_add(&bar[XB_TOP], 1u);
            const unsigned tg = og / nx;
            if (og + 1u == (tg + 1u) * nx) xb_add(&bar[XB_TOPGEN], 1u);
            else XB_SPIN(xb_ld(&bar[XB_TOPGEN]) == tg, bar);
            __builtin_amdgcn_fence(__ATOMIC_ACQUIRE, "agent");
            xb_add(&bar[XB_XGEN(b.x)], 1u);
            asm volatile("s_waitcnt vmcnt(0)" ::: "memory");
        } else {
            XB_SPIN(xb_ld(&bar[XB_XGEN(b.x)]) == gen, bar);
            __builtin_amdgcn_fence(__ATOMIC_ACQUIRE, "agent");
            asm volatile("s_waitcnt vmcnt(0)" ::: "memory");
        }
    }
    __syncthreads();
}

struct EpiAny {
    static constexpr bool PERM = true, AFTER_DRAIN = false;
    unsigned char* ws; const float* xptr; float* optr; int l, k;
    __device__ __forceinline__ void operator()(const pg8::f32x4 (&acc)[2][2][4][2], const pg8::Unit& u, int wr, int wc, int fr, int fq) const {
        const float* PBl = (const float*)(ws + OFF_PB) + (size_t)l * PB_LAYER; const float* modl = (const float*)(ws + OFF_MOD) + (size_t)l * 8 * 6144;
        if (k == 1) { const pg8::EpiInProj E{(pg8::bf16_t*)(ws + OFF_PROJ), PBl + PB_QG, PBl + PB_KG, (float*)(ws + OFF_KMEAN), QSCALE}; E(acc, u, wr, wc, fr, fq); }
        else if (k == 7) { const pg8::EpiH16<1> E{(pg8::bf16_t*)(ws + OFF_HID), FF_}; E(acc, u, wr, wc, fr, fq); }
        else { const bool dn = (k == 8), last = dn && (l == NL_ - 1), first = !dn && (l == 0); h16* XA = (h16*)(ws + OFF_XA);
            const pg8::EpiRes16 E{first ? (const void*)xptr : (const void*)XA, last ? (void*)optr : (void*)XA, D_, modl + (dn ? 5 : 2) * 1024, 6144, first ? 1 : 0, last ? 1 : 0}; E(acc, u, wr, wc, fr, fq); }
    }
};

#define OPQ_S(x) asm volatile("" : "+s"(x))
#define OPQ_V(x) asm volatile("" : "+v"(x))
__global__ void __launch_bounds__(512, 2) fwd_kernel(Args a) {
    extern __shared__ __attribute__((aligned(16))) unsigned char lds_raw[];
    cg::grid_group grid = cg::this_grid();
    LAS unsigned char* lds = (LAS unsigned char*)lds_raw;
    volatile LAS unsigned* barst = (volatile LAS unsigned*)(lds + LDS_BARST);
    if (threadIdx.x < 2) barst[threadIdx.x] = 0u;
    __syncthreads();
    XcdBarrier xbar = xcd_barrier_post((unsigned*)(a.ws + OFF_BAR), barst);
    { const int tid = threadIdx.x, lane = tid & 63, wave = __builtin_amdgcn_readfirstlane(tid >> 6);
      p0_phase(a, lds, tid, lane, wave); }
    grid.sync();
    const float* xptr = a.in[I_X]; float* optr = a.out; unsigned char* wsb = a.ws;
#pragma unroll 1
    for (int step = 0; step < 9 * NL_; ++step) {
        const int l = step / 9, k = step - 9 * l;
#define PH_BEGIN GAS unsigned char* wsg_ = (GAS unsigned char*)wsb; OPQ_S(wsg_); unsigned char* ws = (unsigned char*)wsg_;     int tid = threadIdx.x; OPQ_V(tid); const int lane = tid & 63, wave = __builtin_amdgcn_readfirstlane(tid >> 6); \
        const int G = gridDim.x, gw = blockIdx.x * 8 + wave, NGW = G * 8; (void)gw; (void)NGW; (void)lane; \
        const float* modl = (const float*)(ws + OFF_MOD) + (size_t)l * 8 * 6144; const unsigned char* wl = ws + OFF_W + (size_t)l * W_LAYER; (void)modl; (void)wl; \
        h16* H = (h16*)(ws + OFF_H); h16* XA = (h16*)(ws + OFF_XA); (void)H; (void)XA;
        { PH_BEGIN
          const float* PBl = (const float*)(ws + OFF_PB) + (size_t)l * PB_LAYER;
          if (k == 0 || k == 6) {
              const float* gp = PBl + (k == 0 ? PB_LN1G : PB_LN2G); const int shc = (k == 0) ? 0 : 3, scc = (k == 0) ? 1 : 4;
              if (step == 0) ln_phase<false>(xptr, gp, modl, shc, scc, H, gw, NGW, lane); else ln_phase<true>(XA, gp, modl, shc, scc, H, gw, NGW, lane);
          } else if (k == 2) { lru_phase(ws, l, lds, lane, wave);
          } else if (k == 3) { attn_phase(ws, lds, tid, lane, wave);
          } else if (k == 4) { mixnorm_phase(ws, l, gw, NGW, lane);
          } else {
              const unsigned char* Ap = ws + (k == 5 ? OFF_Y : k == 8 ? OFF_HID : OFF_H);
              const unsigned char* Bp = wl + (k == 1 ? W_IN : k == 5 ? W_OUT : k == 7 ? W_UP : W_DOWN);
              const int Ng = (k == 1) ? NPROJ : (k == 7) ? FF_ : D_, Kg = (k == 8) ? FF_ : D_;
              pg8::Gemm g{(const pg8::bf16_t*)Ap, (const pg8::bf16_t*)Bp, M_, Ng, Kg}; pg8::StaticOrder S; S.init(M_, Ng, G, (int)blockIdx.x);
              EpiAny E{ws, xptr, optr, l, k};
              pg8::gemm_phase<EpiAny, pg8::StaticOrder, true, true>(lds, g, S, E);
          }
        }
        if (step + 1 < 9 * NL_) xcd_barrier(xbar);
    }
}

extern "C" void kernel_launch(void* const* d_in, const int* in_sizes, int n_in, void* d_out, int out_size, void* d_ws, size_t ws_size, hipStream_t stream) {
    static int grid = 0;
    if (grid == 0) {
        if (n_in != 21 || out_size != M_ * D_ || ws_size < WS_END) { fprintf(stderr, "kernel_launch: unexpected shapes (n_in %d out %d ws %zu)\n", n_in, out_size, ws_size); grid = -1; return; }
        int dev = 0, cus = 0, per_cu = 0;
        (void)hipGetDevice(&dev);
        (void)hipDeviceGetAttribute(&cus, hipDeviceAttributeMultiprocessorCount, dev);
        (void)hipFuncSetAttribute((const void*)fwd_kernel, hipFuncAttributeMaxDynamicSharedMemorySize, LDS_BYTES);
        if (hipOccupancyMaxActiveBlocksPerMultiprocessor(&per_cu, (const void*)fwd_kernel, 512, LDS_BYTES) != hipSuccess || per_cu < 1) per_cu = 1;
        (void)hipGetLastError();
        grid = cus * per_cu;
    }
    if (grid < 0) return;
    Args a{};
    for (int i = 0; i < 21; ++i) a.in[i] = (const float*)d_in[i];
    a.out = (float*)d_out; a.ws = (unsigned char*)d_ws;
    (void)hipMemsetAsync((unsigned char*)d_ws + OFF_BAR, 0, BAR_BYTES, stream);
    void* args[] = {&a};
    hipError_t e = hipLaunchCooperativeKernel((const void*)fwd_kernel, dim3(grid), dim3(512), args, LDS_BYTES, stream);
    if (e != hipSuccess) fprintf(stderr, "cooperative launch failed: %s (grid %d)\n", hipGetErrorString(e), grid);
}
```

```cpp
#include <hip/hip_runtime.h>
#include <hip/hip_cooperative_groups.h>
#include <cstdio>
#include <cstdint>
namespace cg = cooperative_groups;
namespace pg8 {
#define PG8_LAS __attribute__((address_space(3)))
typedef unsigned short bf16_t;
typedef _Float16 bf16x8 __attribute__((ext_vector_type(8)));
typedef float f32x4 __attribute__((ext_vector_type(4)));
typedef unsigned u32x4 __attribute__((ext_vector_type(4)));
constexpr int BM = 256, BK = 64, HALF = 128, HTB = HALF * BK * 2  , STAGE_BYTES = 8 * HTB, NXCD = 8, WGM = 4;

__host__ __device__ __forceinline__ int lds_byte(int r, int c) { const int st = (r >> 4) * 2 + (c >> 5), rr = r & 15, cc = c & 31, ob = rr * 64 + cc * 2; return st * 1024 + (ob ^ (((ob >> 9) & 1) << 5)); }
__host__ __device__ __forceinline__ void stage_rc(int b, int& R, int& C) { const int st = b / 1024, sb = b % 1024, swz = sb ^ (((sb >> 9) & 1) << 5); R = (st >> 1) * 16 + swz / 64; C = (st & 1) * 32 + (swz % 64) / 2; }
__host__ __device__ __forceinline__ int perm32(int rho) { const int n = rho >> 4, i = rho & 15; return 8 * (i >> 2) + 4 * n + (i & 3); }

struct Unit { int pm, pn; };
struct Gemm { const bf16_t* A; const bf16_t* Bt; int M, N, K; };

struct StaticOrder {
    int nM, nN, nwg, G, c;
    __host__ __device__ void init(int M, int N, int G_, int c_) { nM = M / BM; nN = N / BM; nwg = nM * nN; G = G_; c = c_; }
    __host__ __device__ bool next(int i, Unit& u) const {
        const long L = (long)i * G + c; if (L >= nwg) return false;
        int wgid = (int)L; { const int q = nwg / NXCD, r = nwg % NXCD, xcd = wgid % NXCD, off = wgid / NXCD; wgid = (xcd < r ? xcd * (q + 1) : r * (q + 1) + (xcd - r) * q) + off; }
        const int nig = WGM * nN, gid = wgid / nig, fm = gid * WGM, gsz = (nM - fm) < WGM ? (nM - fm) : WGM;
        u.pm = fm + ((wgid % nig) % gsz); u.pn = (wgid % nig) / gsz; return true;
    }
    __device__ __forceinline__ void a_ready(const Unit&) const {}
    __device__ __forceinline__ void done(const Unit&) const {}
};
typedef float f32x2 __attribute__((ext_vector_type(2)));
typedef _Float16 h16x2 __attribute__((ext_vector_type(2)));
__device__ __forceinline__ unsigned pk_h2(float lo, float hi) { f32x2 v = {lo, hi}; h16x2 h = __builtin_convertvector(v, h16x2); return __builtin_bit_cast(unsigned, h); }
template <int ACT  > struct EpiH16 {
    static constexpr bool PERM = true, AFTER_DRAIN = false;
    bf16_t* O; int ldc;
    __device__ __forceinline__ void operator()(const f32x4 (&acc)[2][2][4][2], const Unit& u, int wr, int wc, int fr, int fq) const {
        const int row0 = u.pm * BM + wr * 64 + fr; const int col0 = u.pn * BM + wc * 32 + 8 * fq;
#pragma unroll
        for (int ai = 0; ai < 2; ++ai)
#pragma unroll
            for (int m = 0; m < 4; ++m) { bf16_t* rowp = O + (size_t)(row0 + ai * HALF + m * 16) * ldc + col0;
#pragma unroll
                for (int bj = 0; bj < 2; ++bj) { f32x4 v0 = acc[ai][bj][m][0], v1 = acc[ai][bj][m][1];
                    if (ACT == 1) {
#pragma unroll
                        for (int j = 0; j < 4; ++j) { float a = v0[j] > 0.f ? v0[j] : 0.f; v0[j] = a * a; float b = v1[j] > 0.f ? v1[j] : 0.f; v1[j] = b * b; } }
                    u32x4 w; w.x = pk_h2(v0[0], v0[1]); w.y = pk_h2(v0[2], v0[3]); w.z = pk_h2(v1[0], v1[1]); w.w = pk_h2(v1[2], v1[3]);
                    *(u32x4*)(rowp + bj * HALF) = w; } }
    }
};
struct EpiRes {
    static constexpr bool PERM = false, AFTER_DRAIN = false;
    const float* base; float* out; int ldc; const float* gate; int gstride;
    __device__ __forceinline__ void operator()(const f32x4 (&acc)[2][2][4][2], const Unit& u, int wr, int wc, int fr, int fq) const {
        const int row0 = u.pm * BM + wr * 64 + fr, col0 = u.pn * BM + wc * 32 + 4 * fq;
        const float* gp = gate + (size_t)(u.pm >> 4) * gstride + col0;
        f32x4 gv[2][2];
#pragma unroll
        for (int bj = 0; bj < 2; ++bj)
#pragma unroll
            for (int n = 0; n < 2; ++n) gv[bj][n] = *(const f32x4*)(gp + bj * HALF + n * 16);
#pragma unroll
        for (int ai = 0; ai < 2; ++ai)
#pragma unroll
            for (int m = 0; m < 4; ++m) { const size_t off = (size_t)(row0 + ai * HALF + m * 16) * ldc + col0;
#pragma unroll
                for (int bj = 0; bj < 2; ++bj)
#pragma unroll
                    for (int n = 0; n < 2; ++n) { const f32x4 bs = *(const f32x4*)(base + off + bj * HALF + n * 16);
                        *(f32x4*)(out + off + bj * HALF + n * 16) = bs + gv[bj][n] * acc[ai][bj][m][n]; } }
    }
};

struct EpiRes16 {
    static constexpr bool PERM = true, AFTER_DRAIN = false;
    const void* base; void* out; int ldc; const float* gate; int gstride; int base_f32, out_f32;
    __device__ __forceinline__ void operator()(const f32x4 (&acc)[2][2][4][2], const Unit& u, int wr, int wc, int fr, int fq) const {
        const int row0 = u.pm * BM + wr * 64 + fr, col0 = u.pn * BM + wc * 32 + 8 * fq;
        const float* gp = gate + (size_t)(u.pm >> 4) * gstride + col0;
        f32x4 gv[2][2];
#pragma unroll
        for (int bj = 0; bj < 2; ++bj)
#pragma unroll
            for (int n = 0; n < 2; ++n) gv[bj][n] = *(const f32x4*)(gp + bj * HALF + 4 * n);
#pragma unroll
        for (int ai = 0; ai < 2; ++ai)
#pragma unroll
            for (int m = 0; m < 4; ++m) { const size_t off = (size_t)(row0 + ai * HALF + m * 16) * ldc + col0;
#pragma unroll
                for (int bj = 0; bj < 2; ++bj) {
                    f32x4 b0, b1;
                    if (base_f32) { const float* bp = (const float*)base + off + bj * HALF; b0 = *(const f32x4*)bp; b1 = *(const f32x4*)(bp + 4); }
                    else { const bf16x8 hv = *(const bf16x8*)((const bf16_t*)base + off + bj * HALF);
                        b0 = (f32x4){(float)hv[0], (float)hv[1], (float)hv[2], (float)hv[3]}; b1 = (f32x4){(float)hv[4], (float)hv[5], (float)hv[6], (float)hv[7]}; }
                    const f32x4 y0 = b0 + gv[bj][0] * acc[ai][bj][m][0], y1 = b1 + gv[bj][1] * acc[ai][bj][m][1];
                    if (out_f32) { float* op = (float*)out + off + bj * HALF; *(f32x4*)op = y0; *(f32x4*)(op + 4) = y1; }
                    else { u32x4 w; w.x = pk_h2(y0[0], y0[1]); w.y = pk_h2(y0[2], y0[3]); w.z = pk_h2(y1[0], y1[1]); w.w = pk_h2(y1[2], y1[3]);
                        *(u32x4*)((bf16_t*)out + off + bj * HALF) = w; } } }
    }
};
struct EpiInProj {
    static constexpr bool PERM = true, AFTER_DRAIN = false;
    bf16_t* O; const float* qg; const float* kg; float* kmean; float qscale;
    __device__ __forceinline__ void operator()(const f32x4 (&acc)[2][2][4][2], const Unit& u, int wr, int wc, int fr, int fq) const {
        constexpr int LDC = 2816;
        int fr_ = fr, fq_ = fq; asm volatile("" : "+v"(fr_), "+v"(fq_));
        const int row0 = u.pm * BM + wr * 64 + fr_;
        if (u.pn >= 4) {
            const int col0 = u.pn * BM + wc * 32 + 8 * fq_;
#pragma unroll
            for (int ai = 0; ai < 2; ++ai)
#pragma unroll
                for (int m = 0; m < 4; ++m) { bf16_t* rowp = O + (size_t)(row0 + ai * HALF + m * 16) * LDC + col0;
#pragma unroll
                    for (int bj = 0; bj < 2; ++bj) { const f32x4 v0 = acc[ai][bj][m][0], v1 = acc[ai][bj][m][1];
                        u32x4 w; w.x = pk_h2(v0[0], v0[1]); w.y = pk_h2(v0[2], v0[3]); w.z = pk_h2(v1[0], v1[1]); w.w = pk_h2(v1[2], v1[3]);
                        *(u32x4*)(rowp + bj * HALF) = w; } }
        } else {
            const bool isk = u.pn >= 2;
            const float* gp = (isk ? kg : qg) + 8 * fq_; const float gs = isk ? 1.0f : qscale;
            f32x4 gv[2][2];
#pragma unroll
            for (int bj = 0; bj < 2; ++bj)
#pragma unroll
                for (int n = 0; n < 2; ++n) gv[bj][n] = *(const f32x4*)(gp + 32 * bj + 4 * n) * gs;
            const int col0 = u.pn * BM + wc * 64 + 8 * fq_;
#pragma unroll
            for (int ai = 0; ai < 2; ++ai)
#pragma unroll
                for (int m = 0; m < 4; ++m) {
                    float ss = 0.f;
#pragma unroll
                    for (int bj = 0; bj < 2; ++bj)
#pragma unroll
                        for (int n = 0; n < 2; ++n) { const f32x4 v = acc[ai][bj][m][n]; ss += (v[0] * v[0] + v[1] * v[1]) + (v[2] * v[2] + v[3] * v[3]); }
                    ss += __shfl_xor(ss, 16); ss += __shfl_xor(ss, 32);
                    const float r = rsqrtf(ss * (1.0f / 64.0f) + 1e-6f);
                    bf16_t* rowp = O + (size_t)(row0 + ai * HALF + m * 16) * LDC + col0;
#pragma unroll
                    for (int bj = 0; bj < 2; ++bj) { const f32x4 y0 = acc[ai][bj][m][0] * r * gv[bj][0], y1 = acc[ai][bj][m][1] * r * gv[bj][1];
                        u32x4 w; w.x = pk_h2(y0[0], y0[1]); w.y = pk_h2(y0[2], y0[3]); w.z = pk_h2(y1[0], y1[1]); w.w = pk_h2(y1[2], y1[3]);
                        *(u32x4*)(rowp + 32 * bj) = w; }
                    asm volatile("" ::: "memory"); }
        }
    }
};

template <class Epi, class Sched, bool ALIGN_EPI = false, bool SP2 = false>
__device__ __forceinline__ void gemm_phase(PG8_LAS unsigned char* lds, const Gemm g, const Sched& S, const Epi& E) {
    int tid_ = threadIdx.x; asm volatile("" : "+v"(tid_));
    const int tid = tid_, wid = __builtin_amdgcn_readfirstlane(tid >> 6), lane = tid & 63, wr = wid >> 2, wc = wid & 3, fr = lane & 15, fq = lane >> 4;
    const int K = g.K, nt = K / BK;
    unsigned voffA[2], voffB[2];
#pragma unroll
    for (int i = 0; i < 2; ++i) { int R, C; stage_rc(tid * 16 + i * 8192, R, C); const int Rb = Epi::PERM ? ((R & ~31) + perm32(R & 31)) : R;
        voffA[i] = (unsigned)(R * K + C) * 2u; voffB[i] = (unsigned)(Rb * K + C) * 2u; }
    const size_t kstep = (size_t)(BK * 2);
    const size_t hstep = (size_t)HALF * K * 2;
    const size_t tstep = 2 * hstep;
    const unsigned ldsw = (unsigned)wid * 1024u;
    const int aoff = lds_byte(wr * 64 + fr, fq * 8), boff = lds_byte(wc * 32 + fr, fq * 8);
#define PG8_SA(b, h) (((b) * 2 + (h)) * HTB)
#define PG8_SB(b, h) ((4 + (b) * 2 + (h)) * HTB)
#define PG8_STAGE(bufoff, gbase, voff) do { _Pragma("unroll") for (int _i = 0; _i < 2; ++_i) \
        __builtin_amdgcn_global_load_lds((const unsigned*)((const char*)(gbase) + (voff)[_i]), (PG8_LAS unsigned*)(lds + (bufoff) + ldsw + _i * 8192), 16, 0, 0); } while (0)
#define PG8_LDA(dst, b, h) do { _Pragma("unroll") for (int m = 0; m < 4; ++m) _Pragma("unroll") for (int k = 0; k < 2; ++k) dst[m][k] = *(const PG8_LAS bf16x8*)(lds + PG8_SA(b, h) + aoff + m * 2048 + k * 1024); } while (0)
#define PG8_LDB(dst, b, h) do { _Pragma("unroll") for (int n = 0; n < 2; ++n) _Pragma("unroll") for (int k = 0; k < 2; ++k) dst[n][k] = *(const PG8_LAS bf16x8*)(lds + PG8_SB(b, h) + boff + n * 2048 + k * 1024); } while (0)
#define PG8_MMA(ai, bj, At, Bt) do { __builtin_amdgcn_s_setprio(1); _Pragma("unroll") for (int m = 0; m < 4; ++m) _Pragma("unroll") for (int n = 0; n < 2; ++n) _Pragma("unroll") for (int k = 0; k < 2; ++k) \
        acc[ai][bj][m][n] = __builtin_amdgcn_mfma_f32_16x16x32_f16(Bt[n][k], At[m][k], acc[ai][bj][m][n], 0, 0, 0); __builtin_amdgcn_s_setprio(0); } while (0)
#define PG8_WAIT_V(n) asm volatile("s_waitcnt vmcnt(" #n ")" ::: "memory")
#define PG8_WAIT_L(n) asm volatile("s_waitcnt lgkmcnt(" #n ")" ::: "memory")
#define PG8_BAR __builtin_amdgcn_s_barrier()
#define PG8_SCHED __builtin_amdgcn_sched_barrier(0)
    Unit cur, nxt; int ui = 0;
    if (!S.next(0, cur)) return;
    f32x4 acc[2][2][4][2];
#pragma unroll
    for (int a = 0; a < 2; ++a)
#pragma unroll
        for (int b = 0; b < 2; ++b)
#pragma unroll
            for (int m = 0; m < 4; ++m)
#pragma unroll
                for (int n = 0; n < 2; ++n) acc[a][b][m][n] = (f32x4){0.f, 0.f, 0.f, 0.f};
    bf16x8 At[4][2], B0[2][2], B1[2][2];
    const char* cA = (const char*)g.A + (size_t)cur.pm * tstep; const char* cB = (const char*)g.Bt + (size_t)cur.pn * tstep;
    S.a_ready(cur);
    if constexpr (SP2) {
        PG8_STAGE(PG8_SB(0, 0), cB, voffB); PG8_STAGE(PG8_SB(0, 1), cB + hstep, voffB); PG8_STAGE(PG8_SA(0, 0), cA, voffA); PG8_STAGE(PG8_SA(0, 1), cA + hstep, voffA);
        if (wr == 1) PG8_BAR;
        PG8_WAIT_V(2); PG8_BAR;
        PG8_STAGE(PG8_SB(1, 0), cB + kstep, voffB); PG8_STAGE(PG8_SA(1, 0), cA + kstep, voffA); PG8_STAGE(PG8_SB(1, 1), cB + hstep + kstep, voffB);
        PG8_WAIT_V(6); PG8_BAR;
    } else {
        PG8_STAGE(PG8_SB(0, 0), cB, voffB); PG8_STAGE(PG8_SA(0, 0), cA, voffA); PG8_STAGE(PG8_SB(0, 1), cB + hstep, voffB); PG8_STAGE(PG8_SA(0, 1), cA + hstep, voffA);
        if (wr == 1) PG8_BAR;
        PG8_WAIT_V(4); PG8_BAR;
        PG8_STAGE(PG8_SB(1, 0), cB + kstep, voffB); PG8_STAGE(PG8_SA(1, 0), cA + kstep, voffA); PG8_STAGE(PG8_SB(1, 1), cB + hstep + kstep, voffB);
        PG8_WAIT_V(6); PG8_BAR;
    }
    for (;;) {
        const bool has_next = S.next(ui + 1, nxt);
        const char* nA = has_next ? (const char*)g.A + (size_t)nxt.pm * tstep : cA; const char* nB = has_next ? (const char*)g.Bt + (size_t)nxt.pn * tstep : cB;
        for (int t = 0; t < nt; t += 2) {
            const bool last = (t == nt - 2);
            const char* a1 = cA + (size_t)(t + 1) * kstep;
            const char* a2 = last ? nA : cA + (size_t)(t + 2) * kstep; const char* b2 = last ? nB : cB + (size_t)(t + 2) * kstep;
            const char* a3 = a2 + kstep; const char* b3 = b2 + kstep;
            if (last && has_next) S.a_ready(nxt);
            if constexpr (SP2) {
            PG8_LDB(B0, 0, 0); PG8_LDB(B1, 0, 1); PG8_SCHED; PG8_LDA(At, 0, 0); PG8_STAGE(PG8_SA(1, 1), a1 + hstep, voffA);
            PG8_WAIT_V(8); PG8_WAIT_L(0); PG8_BAR; PG8_MMA(0, 0, At, B0); PG8_MMA(0, 1, At, B1); PG8_BAR; PG8_SCHED;
            PG8_LDA(At, 0, 1); PG8_STAGE(PG8_SB(0, 0), b2, voffB); PG8_STAGE(PG8_SB(0, 1), b2 + hstep, voffB); PG8_STAGE(PG8_SA(0, 0), a2, voffA);
            PG8_WAIT_V(8); PG8_WAIT_L(0); PG8_BAR; PG8_MMA(1, 0, At, B0); PG8_MMA(1, 1, At, B1); PG8_BAR; PG8_SCHED;
            PG8_LDB(B0, 1, 0); PG8_LDB(B1, 1, 1); PG8_SCHED; PG8_LDA(At, 1, 0); PG8_STAGE(PG8_SA(0, 1), a2 + hstep, voffA);
            PG8_WAIT_V(8); PG8_WAIT_L(0); PG8_BAR; PG8_MMA(0, 0, At, B0); PG8_MMA(0, 1, At, B1); PG8_BAR; PG8_SCHED;
            PG8_LDA(At, 1, 1); PG8_STAGE(PG8_SB(1, 0), b3, voffB); PG8_STAGE(PG8_SB(1, 1), b3 + hstep, voffB); PG8_STAGE(PG8_SA(1, 0), a3, voffA);
            PG8_WAIT_V(8); PG8_WAIT_L(0); PG8_BAR; PG8_MMA(1, 0, At, B0); PG8_MMA(1, 1, At, B1); PG8_BAR; PG8_SCHED;
            } else {
            PG8_LDB(B0, 0, 0); PG8_SCHED; PG8_LDA(At, 0, 0); PG8_STAGE(PG8_SA(1, 1), a1 + hstep, voffA);
            PG8_WAIT_L(8); PG8_BAR; PG8_WAIT_L(0); PG8_MMA(0, 0, At, B0); PG8_BAR; PG8_SCHED;
            PG8_LDB(B1, 0, 1); PG8_STAGE(PG8_SB(0, 0), b2, voffB);
            PG8_BAR; PG8_WAIT_L(0); PG8_MMA(0, 1, At, B1); PG8_BAR;
            PG8_LDA(At, 0, 1); PG8_STAGE(PG8_SA(0, 0), a2, voffA);
            PG8_BAR; PG8_WAIT_L(0); PG8_MMA(1, 0, At, B0); PG8_BAR; PG8_SCHED;
            PG8_STAGE(PG8_SB(0, 1), b2 + hstep, voffB);
            PG8_WAIT_V(6); PG8_BAR; PG8_MMA(1, 1, At, B1); PG8_BAR;
            PG8_LDB(B0, 1, 0); PG8_SCHED; PG8_LDA(At, 1, 0); PG8_STAGE(PG8_SA(0, 1), a2 + hstep, voffA);
            PG8_WAIT_L(8); PG8_BAR; PG8_WAIT_L(0); PG8_MMA(0, 0, At, B0); PG8_BAR; PG8_SCHED;
            PG8_LDB(B1, 1, 1); PG8_STAGE(PG8_SB(1, 0), b3, voffB);
            PG8_BAR; PG8_WAIT_L(0); PG8_MMA(0, 1, At, B1); PG8_BAR;
            PG8_LDA(At, 1, 1); PG8_STAGE(PG8_SA(1, 0), a3, voffA);
            PG8_BAR; PG8_WAIT_L(0); PG8_MMA(1, 0, At, B0); PG8_BAR; PG8_SCHED;
            PG8_STAGE(PG8_SB(1, 1), b3 + hstep, voffB);
            PG8_WAIT_V(6); PG8_BAR; PG8_MMA(1, 1, At, B1); PG8_BAR;
            }
        }
        if constexpr (ALIGN_EPI) { if (wr == 0) PG8_BAR; }
        if constexpr (!Epi::AFTER_DRAIN) { E(acc, cur, wr, wc, fr, fq); S.done(cur); }
        if (!has_next) break;
#pragma unroll
        for (int a = 0; a < 2; ++a)
#pragma unroll
            for (int b = 0; b < 2; ++b)
#pragma unroll
                for (int m = 0; m < 4; ++m)
#pragma unroll
                    for (int n = 0; n < 2; ++n) acc[a][b][m][n] = (f32x4){0.f, 0.f, 0.f, 0.f};
        cur = nxt; cA = nA; cB = nB; ++ui;
        if constexpr (ALIGN_EPI) { if (wr == 1) PG8_BAR; }
    }
    PG8_WAIT_V(0);
    if constexpr (!ALIGN_EPI) { if (wr == 0) PG8_BAR; }
    PG8_BAR;
    if constexpr (Epi::AFTER_DRAIN) { E.fused(acc, cur, wr, wc, fr, fq, lds, wid, lane); S.done(cur); }
#undef PG8_SA
#undef PG8_SB
#undef PG8_STAGE
#undef PG8_LDA
#undef PG8_LDB
#undef PG8_MMA
#undef PG8_WAIT_V
#undef PG8_WAIT_L
#undef PG8_BAR
#undef PG8_SCHED
}
}
#define LAS __attribute__((address_space(3)))
#define GAS __attribute__((address_space(1)))
typedef _Float16 h16;
typedef _Float16 h16x8 __attribute__((ext_vector_type(8)));
typedef _Float16 h16x4 __attribute__((ext_vector_type(4)));
typedef _Float16 h16x2v __attribute__((ext_vector_type(2)));
typedef float f32x2 __attribute__((ext_vector_type(2)));
typedef float f32x4 __attribute__((ext_vector_type(4)));
typedef float f32x16 __attribute__((ext_vector_type(16)));
typedef unsigned u32x4 __attribute__((ext_vector_type(4)));
typedef unsigned u32x2 __attribute__((ext_vector_type(2)));
constexpr int B_ = 8, S_ = 4096, D_ = 1024, M_ = B_ * S_, NPROJ = 2816, FF_ = 4096, NL_ = 2;
constexpr int C_Q = 0, C_K = 512, C_V = 1024, C_SCB = 1536, C_SCC = 1792, C_SCU = 2048, C_LX = 2304, C_LG = 2560;
constexpr float EPS_ = 1e-6f, QSCALE = 0.125f * 1.4426950408889634f;
constexpr size_t MiB = 1u << 20;
constexpr size_t OFF_MOD = 0, OFF_KMEAN = 384 * 1024, OFF_PB = 640 * 1024, OFF_AGG = 1 * MiB, OFF_CARRY = 3 * MiB, OFF_W = 4 * MiB;
constexpr int PB_LN1G = 0, PB_LN2G = 1024, PB_QG = 2048, PB_KG = 2112, PB_SCW = 2176, PB_LCW = 2944, PB_LCB = 3968, PB_LWA = 4224, PB_LBA = 20608,
              PB_LWX = 20864, PB_LBX = 37248, PB_LAM = 37504, PB_MIXG = 37760, PB_LAYER = 38784;
static_assert(OFF_PB + 2 * PB_LAYER * 4 <= OFF_AGG, "pb map");
constexpr size_t W_IN = 0, W_OUT = 5767168, W_UP = 7864320, W_DOWN = 16252928, W_LAYER = 24641536;
constexpr size_t OFF_XA = 52 * MiB, OFF_H = 180 * MiB, OFF_YATT = OFF_H, OFF_PCUM = OFF_H + 32 * MiB, OFF_HLOC = OFF_H + 48 * MiB;
constexpr size_t OFF_BIG = 244 * MiB, OFF_PROJ = OFF_BIG, OFF_Y = OFF_BIG + 176 * MiB, OFF_VT = OFF_Y, OFF_HID = OFF_BIG, WS_END = 500 * MiB;
constexpr size_t OFF_WF = 51 * MiB, OFF_SP = 51 * MiB + 256 * 1024;
constexpr int LDS_BYTES = 147456, LDS_BARST = 147456 - 64;
constexpr size_t OFF_BAR = 960 * 1024, BAR_BYTES = 16384;
static_assert(OFF_W + 2 * W_LAYER <= OFF_XA, "ws map");

struct Args { const float* in[21]; float* out; unsigned char* ws; };
enum { I_X = 0, I_C, I_LN1G, I_LN2G, I_WADA, I_BADA, I_WIN, I_QG, I_KG, I_SCW, I_LCW, I_LCB, I_LWA, I_LBA, I_LWX, I_LBX, I_LAM, I_MIXG, I_WOUT, I_WUP, I_WDOWN };

#define LDS_WAIT() asm volatile("s_waitcnt lgkmcnt(0)" ::: "memory")
#define WG_BAR() do { asm volatile("s_waitcnt lgkmcnt(0)" ::: "memory"); __builtin_amdgcn_s_barrier(); asm volatile("" ::: "memory"); } while (0)
__device__ __forceinline__ float wave_sum(float v) {
#pragma unroll
    for (int o = 1; o < 64; o <<= 1) v += __shfl_xor(v, o);
    return v;
}
__device__ __forceinline__ unsigned pkh(float lo, float hi) { f32x2 v = {lo, hi}; h16x2v h = __builtin_convertvector(v, h16x2v); return __builtin_bit_cast(unsigned, h); }
__device__ __forceinline__ float sigmoidf_(float x) { return 1.0f / (1.0f + __expf(-x)); }

__device__ __forceinline__ void transpose_item(const bool HEADPERM, const float* W, int K, int N, h16* WT, LAS float* scr, int item, int lane) {
    const int nblk = N / 32, kb = item / nblk, nb = item % nblk, k0 = 64 * kb, n0 = 32 * nb;
#pragma unroll 8
    for (int i = 0; i < 32; ++i) { const int kk = 2 * i + (lane >> 5); scr[kk * 33 + (lane & 31)] = W[(size_t)(k0 + kk) * N + n0 + (lane & 31)]; }
    LDS_WAIT();
    const int c = lane & 7;
#pragma unroll
    for (int j = 0; j < 4; ++j) { const int n = (lane >> 3) + 8 * j; const LAS float* s = scr + (8 * c) * 33 + n;
        u32x4 o; o.x = pkh(s[0 * 33], s[1 * 33]); o.y = pkh(s[2 * 33], s[3 * 33]); o.z = pkh(s[4 * 33], s[5 * 33]); o.w = pkh(s[6 * 33], s[7 * 33]);
        int nr = n0 + n;
        if (HEADPERM && nr < 1024) { const int a = nr & 255; nr = (nr & ~255) + 128 * ((a >> 5) & 1) + 32 * (a >> 6) + (a & 31); }
        *(u32x4*)(WT + (size_t)nr * K + k0 + 8 * c) = o; }
    LDS_WAIT();
}
__device__ __forceinline__ void p0_phase(const Args& a, LAS unsigned char* lds, int tid, int lane, int wave) {
    unsigned char* ws = a.ws;
    LAS float* CA = (LAS float*)(lds + 69632);
    LAS float* RED = (LAS float*)(lds + 102400);
    for (int i = tid; i < B_ * D_; i += 512) { const float cv = a.in[I_C][i]; CA[i] = cv / (1.0f + __expf(-cv)); }
    __syncthreads();
    float* MOD = (float*)(ws + OFF_MOD);
    for (int it = blockIdx.x; it < 2 * 96; it += gridDim.x) {
        const int l = it / 96, cgp = it % 96, n = cgp * 64 + lane;
        const float* wp = a.in[I_WADA] + ((size_t)l * D_ + wave * 128) * 6144 + n;
        float acc[8];
#pragma unroll
        for (int b = 0; b < 8; ++b) acc[b] = 0.f;
#pragma unroll 8
        for (int kk = 0; kk < 128; ++kk) { const float wv = wp[(size_t)kk * 6144]; const int k = wave * 128 + kk;
#pragma unroll
            for (int b = 0; b < 8; ++b) acc[b] += CA[b * 1024 + k] * wv; }
#pragma unroll
        for (int b = 0; b < 8; ++b) RED[(wave * 8 + b) * 64 + lane] = acc[b];
        __syncthreads();
        { const int b = wave; float s = 0.f;
#pragma unroll
          for (int w2 = 0; w2 < 8; ++w2) s += RED[(w2 * 8 + b) * 64 + lane];
          MOD[((size_t)l * 8 + b) * 6144 + n] = s + a.in[I_BADA][l * 6144 + n]; }
        __syncthreads();
    }
    { float* PB = (float*)(ws + OFF_PB); const int gt = blockIdx.x * 512 + tid, NT = gridDim.x * 512;
#define CP(idx, off, len) for (int i = gt; i < 2 * (len); i += NT) { const int l = i / (len), r = i % (len); PB[l * PB_LAYER + (off) + r] = a.in[idx][i]; }
      CP(I_LN1G, PB_LN1G, 1024) CP(I_LN2G, PB_LN2G, 1024) CP(I_QG, PB_QG, 64) CP(I_KG, PB_KG, 64) CP(I_SCW, PB_SCW, 768) CP(I_LCW, PB_LCW, 1024) CP(I_LCB, PB_LCB, 256)
      CP(I_LWA, PB_LWA, 16384) CP(I_LBA, PB_LBA, 256) CP(I_LWX, PB_LWX, 16384) CP(I_LBX, PB_LBX, 256) CP(I_LAM, PB_LAM, 256) CP(I_MIXG, PB_MIXG, 1024)
#undef CP
    }
    { h16* WF = (h16*)(ws + OFF_WF); float* SP = (float*)(ws + OFF_SP); const int gt = blockIdx.x * 512 + tid, NT = gridDim.x * 512;
      for (int i = gt; i < 65536; i += NT) { const int e = i & 7, ln = (i >> 3) & 63, ks = (i >> 9) & 1, gate = (i >> 10) & 1, jt = (i >> 11) & 3, hh = (i >> 13) & 3, l = i >> 15;
          const int ii = 32 * ks + 8 * (ln >> 4) + e, jj = 16 * jt + (ln & 15);
          WF[i] = (h16)a.in[gate ? I_LWX : I_LWA][((size_t)(l * 4 + hh) * 64 + ii) * 64 + jj]; }
      for (int i = gt; i < 512; i += NT) SP[i] = log1pf(__expf(-a.in[I_LAM][i])); }
    LAS float* scr = (LAS float*)(lds + wave * 8448);
    const int gw = blockIdx.x * 8 + wave, NGW = gridDim.x * 8;
    constexpr int I_A = 16 * 88, I_B = 16 * 32, I_C2 = 16 * 128, I_D = 64 * 32, I_L = I_A + I_B + I_C2 + I_D;
    for (int it = gw; it < 2 * I_L; it += NGW) {
        const int l = it / I_L; int r = it % I_L;
        unsigned char* wl = ws + OFF_W + (size_t)l * W_LAYER;
        const float* src; int Kt, Nt; size_t dof; bool hp = false;
        if (r < I_A) { src = a.in[I_WIN] + (size_t)l * D_ * NPROJ; Kt = D_; Nt = NPROJ; dof = W_IN; hp = true; }
        else if ((r -= I_A) < I_B) { src = a.in[I_WOUT] + (size_t)l * D_ * D_; Kt = D_; Nt = D_; dof = W_OUT; }
        else if ((r -= I_B) < I_C2) { src = a.in[I_WUP] + (size_t)l * D_ * FF_; Kt = D_; Nt = FF_; dof = W_UP; }
        else { r -= I_C2; src = a.in[I_WDOWN] + (size_t)l * FF_ * D_; Kt = FF_; Nt = D_; dof = W_DOWN; }
        transpose_item(hp, src, Kt, Nt, (h16*)(wl + dof), scr, r, lane);
    }
}

__device__ __forceinline__ void ln_phase(const bool XH16, const void* xv_, const float* g, const float* modl, int shift_chunk, int scale_chunk, h16* H, int gw, int NGW, int lane) {
    for (int row0 = gw * 4; row0 < M_; row0 += NGW * 4) {
        const int b = row0 >> 12;
        const float* mb = modl + (size_t)b * 6144;
        f32x4 v[4][4]; float ss[4];
#pragma unroll
        for (int r = 0; r < 4; ++r) {
            if (XH16) { const h16x4* xr = (const h16x4*)((const h16*)xv_ + (size_t)(row0 + r) * D_) + lane;
#pragma unroll
                for (int j = 0; j < 4; ++j) { const h16x4 hv = xr[64 * j];
                    v[r][j] = (f32x4){(float)hv[0], (float)hv[1], (float)hv[2], (float)hv[3]}; } }
            else { const f32x4* xr = (const f32x4*)((const float*)xv_ + (size_t)(row0 + r) * D_) + lane;
#pragma unroll
                for (int j = 0; j < 4; ++j) v[r][j] = xr[64 * j]; } }
        f32x4 cs[4], sh[4];
#pragma unroll
        for (int j = 0; j < 4; ++j) { const int col = 256 * j + 4 * lane;
            cs[j] = *(const f32x4*)(g + col) * (*(const f32x4*)(mb + scale_chunk * 1024 + col) + 1.0f); sh[j] = *(const f32x4*)(mb + shift_chunk * 1024 + col); }
#pragma unroll
        for (int r = 0; r < 4; ++r) { float s = 0.f;
#pragma unroll
            for (int j = 0; j < 4; ++j) s += (v[r][j].x * v[r][j].x + v[r][j].y * v[r][j].y) + (v[r][j].z * v[r][j].z + v[r][j].w * v[r][j].w);
            ss[r] = s; }
#pragma unroll
        for (int o = 1; o < 64; o <<= 1) {
#pragma unroll
            for (int r = 0; r < 4; ++r) ss[r] += __shfl_xor(ss[r], o); }
#pragma unroll
        for (int r = 0; r < 4; ++r) { const float rr = rsqrtf(ss[r] * (1.0f / D_) + EPS_);
#pragma unroll
            for (int j = 0; j < 4; ++j) { const int col = 256 * j + 4 * lane; const f32x4 y = v[r][j] * rr * cs[j] + sh[j];
                u32x2 o; o.x = pkh(y.x, y.y); o.y = pkh(y.z, y.w);
                *(u32x2*)(H + (size_t)(row0 + r) * D_ + col) = o; } }
    }
}

__device__ __forceinline__ void lru_phase(unsigned char* ws, int l, LAS unsigned char* lds, int lane, int wave) {
    const float* PB = (const float*)(ws + OFF_PB) + (size_t)l * PB_LAYER;
    const h16* WF = (const h16*)(ws + OFF_WF) + (size_t)l * 32768; const float* SP = (const float*)(ws + OFF_SP) + l * 256;
    const h16* PROJ = (const h16*)(ws + OFF_PROJ);
    h16* HLOC = (h16*)(ws + OFF_HLOC); h16* PCUM = (h16*)(ws + OFF_PCUM); float* AGG = (float*)(ws + OFF_AGG);
    LAS h16* XH = (LAS h16*)(lds + wave * 17408);
    LAS float* XF = (LAS float*)(lds + wave * 17408 + 4608);
    LAS h16* OP = (LAS h16*)(lds + wave * 17408 + 12800);
    { float* KMEAN = (float*)(ws + OFF_KMEAN); const int c8 = lane & 7, r8 = lane >> 3;
      for (int wi = blockIdx.x * 8 + wave; wi < B_ * 8 * 16; wi += gridDim.x * 8) {
          const int b = wi >> 7, n = (wi >> 3) & 15, h = wi & 7;
          const h16* base = PROJ + ((size_t)b * S_ + n * 256 + r8) * NPROJ + C_K + h * 64 + 8 * c8;
          float ks[8];
#pragma unroll
          for (int j = 0; j < 8; ++j) ks[j] = 0.f;
#pragma unroll 8
          for (int i = 0; i < 32; ++i) { const h16x8 v = *(const h16x8*)(base + (size_t)(8 * i) * NPROJ);
#pragma unroll
              for (int j = 0; j < 8; ++j) ks[j] += (float)v[j]; }
#pragma unroll
          for (int j = 0; j < 8; ++j) { float s = ks[j]; s += __shfl_xor(s, 8); s += __shfl_xor(s, 16); s += __shfl_xor(s, 32); ks[j] = s * (1.0f / 256.0f); }
          if (lane < 8) { float* kp = KMEAN + ((size_t)(b * 8 + h) * 16 + n) * 64 + 8 * lane; *(f32x4*)kp = (f32x4){ks[0], ks[1], ks[2], ks[3]}; *(f32x4*)(kp + 4) = (f32x4){ks[4], ks[5], ks[6], ks[7]}; } } }
    const int j16 = lane & 15, q4 = lane >> 4;
    for (int wi = blockIdx.x * 8 + wave; wi < B_ * 128 * 4; wi += gridDim.x * 8) {
        const int b = wi >> 9, chn = (wi >> 2) & 127, hh = wi & 3, t0 = chn * 32;
        { const int cj = hh * 64 + lane;
          const float* cwp = PB + PB_LCW + cj;
          const float cw0 = cwp[0], cw1 = cwp[256], cw2 = cwp[512], cw3 = cwp[768], cb = PB[PB_LCB + cj];
          const h16* lx = PROJ + ((size_t)b * S_ + t0) * NPROJ + C_LX + cj;
          h16 xin[35];
#pragma unroll
          for (int t = 0; t < 3; ++t) xin[t] = (t0 > 0) ? lx[(t - 3) * NPROJ] : (h16)0.f;
#pragma unroll
          for (int t = 0; t < 32; ++t) xin[3 + t] = lx[(size_t)t * NPROJ];
#pragma unroll
          for (int t = 0; t < 32; ++t) { const float xr = cw0 * (float)xin[t] + cw1 * (float)xin[t + 1] + cw2 * (float)xin[t + 2] + cw3 * (float)xin[t + 3] + cb;
              XF[t * 64 + lane] = xr; XH[t * 72 + lane] = (h16)xr; } }
        LDS_WAIT();
        h16x8 afr[2][2];
#pragma unroll
        for (int tt = 0; tt < 2; ++tt)
#pragma unroll
            for (int ks = 0; ks < 2; ++ks) afr[tt][ks] = *(const LAS h16x8*)(XH + (16 * tt + j16) * 72 + 32 * ks + 8 * q4);
        LDS_WAIT();
        const size_t tokb = (size_t)b * S_ + t0;
#pragma unroll 1
        for (int jt = 0; jt < 4; ++jt) {
            const int j = 16 * jt + j16, cj = hh * 64 + j;
            const h16* wfp = WF + (size_t)((hh * 4 + jt) * 4) * 512 + lane * 8;
            const h16x8 wfa0 = *(const h16x8*)(wfp), wfa1 = *(const h16x8*)(wfp + 512), wfx0 = *(const h16x8*)(wfp + 1024), wfx1 = *(const h16x8*)(wfp + 1536);
            f32x4 pa[2], px[2];
#pragma unroll
            for (int tt = 0; tt < 2; ++tt) { pa[tt] = (f32x4){0.f, 0.f, 0.f, 0.f}; px[tt] = (f32x4){0.f, 0.f, 0.f, 0.f};
                pa[tt] = __builtin_amdgcn_mfma_f32_16x16x32_f16(afr[tt][0], wfa0, pa[tt], 0, 0, 0); pa[tt] = __builtin_amdgcn_mfma_f32_16x16x32_f16(afr[tt][1], wfa1, pa[tt], 0, 0, 0);
                px[tt] = __builtin_amdgcn_mfma_f32_16x16x32_f16(afr[tt][0], wfx0, px[tt], 0, 0, 0); px[tt] = __builtin_amdgcn_mfma_f32_16x16x32_f16(afr[tt][1], wfx1, px[tt], 0, 0, 0); }
            const float ba = PB[PB_LBA + cj], bx = PB[PB_LBX + cj], sp = SP[cj];
            float cA = 1.f, cH = 0.f;
#pragma unroll
            for (int tt = 0; tt < 2; ++tt) {
                float av[4], hv[4]; float hr = 0.f, pr_ = 1.f;
#pragma unroll
                for (int r = 0; r < 4; ++r) { const int t = 16 * tt + 4 * q4 + r; const float xv = XF[t * 64 + j];
                    const float rg = __builtin_amdgcn_rcpf(1.0f + __expf(-(pa[tt][r] + ba))), ig = __builtin_amdgcn_rcpf(1.0f + __expf(-(px[tt][r] + bx)));
                    const float la = -8.0f * rg * sp, aa = __expf(la);
                    const float u = sqrtf(fmaxf(1.0f - aa * aa, 0.f)) * (ig * xv);
                    hr = aa * hr + u; pr_ *= aa; hv[r] = hr; av[r] = pr_; }
                float Ai = pr_, Hi = hr;
                { const float Ap = __shfl_up(Ai, 16), Hp = __shfl_up(Hi, 16); if (q4 >= 1) { Hi = Ai * Hp + Hi; Ai = Ai * Ap; } }
                { const float Ap = __shfl_up(Ai, 32), Hp = __shfl_up(Hi, 32); if (q4 >= 2) { Hi = Ai * Hp + Hi; Ai = Ai * Ap; } }
                float Ae = __shfl_up(Ai, 16), He = __shfl_up(Hi, 16); if (q4 == 0) { Ae = 1.f; He = 0.f; }
                const float Hin = Ae * cH + He, Ain = Ae * cA;
#pragma unroll
                for (int r = 0; r < 4; ++r) { const int t = 16 * tt + 4 * q4 + r; XH[t * 72 + j] = (h16)(hv[r] + av[r] * Hin); OP[t * 72 + j] = (h16)(av[r] * Ain); }
                const float At = __shfl(Ai, 48 + j16), Ht = __shfl(Hi, 48 + j16);
                cH = At * cH + Ht; cA = At * cA;
            }
            if (q4 == 0) { float* ag = AGG + (((size_t)b * 128 + chn) * 256 + cj) * 2; *(f32x2*)ag = (f32x2){cA, cH}; }
        }
        LDS_WAIT();
#pragma unroll
        for (int k = 0; k < 4; ++k) { const int id2 = k * 64 + lane, t = id2 >> 3, c8 = id2 & 7; const size_t o = (tokb + t) * 256 + hh * 64 + 8 * c8;
            *(u32x4*)(HLOC + o) = *(const LAS u32x4*)(XH + t * 72 + 8 * c8); *(u32x4*)(PCUM + o) = *(const LAS u32x4*)(OP + t * 72 + 8 * c8); }
        LDS_WAIT();
    }
}

typedef short s16x4v __attribute__((ext_vector_type(4)));
__device__ __forceinline__ h16x4 vtr4(const LAS h16* p) { return __builtin_bit_cast(h16x4, __builtin_amdgcn_ds_read_tr16_b64_v4i16((LAS s16x4v*)p)); }
constexpr int AT_KP = 72, AT_VP = 96;
constexpr int AT_KB = 128 * AT_KP, AT_VB = 128 * AT_VP;
template <bool OWN>
__device__ __forceinline__ void attn_tile(const LAS h16* Kt0, const LAS h16* Vt0, const h16x8 (&qf)[4], f32x16& o0, f32x16& o1, float& m_run, float& l_run,
                                          bool lsel, int kt, int w, int r32, int hi, int sig, int vbase) {
    f32x16 sa[2][2];
    if (!OWN) {
#pragma unroll
        for (int st = 0; st < 2; ++st) {
            const LAS h16* Kt = Kt0 + 64 * st * AT_KP;
            h16x8 kf[2][4];
#pragma unroll
            for (int sh = 0; sh < 2; ++sh)
#pragma unroll
                for (int ks = 0; ks < 4; ++ks) kf[sh][ks] = *(const LAS h16x8*)(Kt + (32 * sh + sig) * AT_KP + 16 * ks + 8 * hi);
#pragma unroll
            for (int i = 0; i < 16; ++i) { sa[st][0][i] = 0.f; sa[st][1][i] = 0.f; }
#pragma unroll
            for (int ks = 0; ks < 4; ++ks) { sa[st][0] = __builtin_amdgcn_mfma_f32_32x32x16_f16(kf[0][ks], qf[ks], sa[st][0], 0, 0, 0);
                                             sa[st][1] = __builtin_amdgcn_mfma_f32_32x32x16_f16(kf[1][ks], qf[ks], sa[st][1], 0, 0, 0); }
        }
    }
    if (!OWN) {
        float mx = fmaxf(fmaxf(sa[0][0][0], sa[0][1][0]), fmaxf(sa[1][0][0], sa[1][1][0]));
#pragma unroll
        for (int i = 1; i < 16; ++i) mx = fmaxf(mx, fmaxf(fmaxf(sa[0][0][i], sa[0][1][i]), fmaxf(sa[1][0][i], sa[1][1][i])));
        mx = fmaxf(mx, __shfl_xor(mx, 32));
        mx = lsel ? mx : -INFINITY;
        if (__any(mx > m_run + 8.0f)) {
            const float m_new = (mx > m_run + 8.0f) ? mx : m_run;
            const float alpha = __builtin_amdgcn_exp2f(m_run - m_new);
            m_run = m_new; l_run *= alpha;
#pragma unroll
            for (int i = 0; i < 16; ++i) { o0[i] *= alpha; o1[i] *= alpha; }
        }
        const float m_eff = lsel ? m_run : INFINITY;
        float ps = 0.f;
#pragma unroll
        for (int st = 0; st < 2; ++st)
#pragma unroll
            for (int sh = 0; sh < 2; ++sh) {
#pragma unroll
                for (int i = 0; i < 16; ++i) { sa[st][sh][i] = __builtin_amdgcn_exp2f(sa[st][sh][i] - m_eff); ps += sa[st][sh][i]; }
#pragma unroll
                for (int s2 = 0; s2 < 2; ++s2) {
                    h16x8 pf;
#pragma unroll
                    for (int j = 0; j < 8; ++j) pf[j] = (h16)sa[st][sh][8 * s2 + j];
                    const LAS h16* vp = Vt0 + vbase + (64 * st + 32 * sh + 16 * s2) * AT_VP;
                    const h16x8 v0 = __builtin_shufflevector(vtr4(vp), vtr4(vp + 4 * AT_VP), 0, 1, 2, 3, 4, 5, 6, 7);
                    const h16x8 v1 = __builtin_shufflevector(vtr4(vp + 32), vtr4(vp + 4 * AT_VP + 32), 0, 1, 2, 3, 4, 5, 6, 7);
                    o0 = __builtin_amdgcn_mfma_f32_32x32x16_f16(v0, pf, o0, 0, 0, 0);
                    o1 = __builtin_amdgcn_mfma_f32_32x32x16_f16(v1, pf, o1, 0, 0, 0); } }
        l_run += ps;
        return;
    }
#pragma unroll
    for (int st = 0; st < 2; ++st) {
        const int j16 = kt * 2 + st;
        if (OWN && 2 * j16 > w) continue;
        const LAS h16* Kt = Kt0 + 64 * st * AT_KP; const LAS h16* Vt = Vt0 + 64 * st * AT_VP + vbase;
        f32x16 s0, s1;
        if (OWN) {
            h16x8 kf[2][4];
#pragma unroll
            for (int sh = 0; sh < 2; ++sh)
#pragma unroll
                for (int ks = 0; ks < 4; ++ks) kf[sh][ks] = *(const LAS h16x8*)(Kt + (32 * sh + sig) * AT_KP + 16 * ks + 8 * hi);
#pragma unroll
            for (int i = 0; i < 16; ++i) { s0[i] = 0.f; s1[i] = 0.f; }
#pragma unroll
            for (int ks = 0; ks < 4; ++ks) { s0 = __builtin_amdgcn_mfma_f32_32x32x16_f16(kf[0][ks], qf[ks], s0, 0, 0, 0);
                                             s1 = __builtin_amdgcn_mfma_f32_32x32x16_f16(kf[1][ks], qf[ks], s1, 0, 0, 0); }
        } else { s0 = sa[st][0]; s1 = sa[st][1]; }
        if (OWN) {
            const int rel0 = 2 * j16 - w;
            if (rel0 == 0) {
#pragma unroll
                for (int i = 0; i < 16; ++i) { const int key = (i & 3) + 4 * ((i >> 2) & 1) + 8 * hi + 16 * (i >> 3); s0[i] = key <= r32 ? s0[i] : -INFINITY; } }
            if (rel0 + 1 > 0) {
#pragma unroll
                for (int i = 0; i < 16; ++i) s1[i] = -INFINITY; }
            else if (rel0 + 1 == 0) {
#pragma unroll
                for (int i = 0; i < 16; ++i) { const int key = (i & 3) + 4 * ((i >> 2) & 1) + 8 * hi + 16 * (i >> 3); s1[i] = key <= r32 ? s1[i] : -INFINITY; } }
        }
        float mx = fmaxf(s0[0], s1[0]);
#pragma unroll
        for (int i = 1; i < 16; ++i) mx = fmaxf(mx, fmaxf(s0[i], s1[i]));
        mx = fmaxf(mx, __shfl_xor(mx, 32));
        if (!OWN) mx = lsel ? mx : -INFINITY;
        if (__any(mx > m_run + 8.0f)) {
            const float m_new = (mx > m_run + 8.0f) ? mx : m_run;
            const float alpha = __builtin_amdgcn_exp2f(m_run - m_new);
            m_run = m_new; l_run *= alpha;
#pragma unroll
            for (int i = 0; i < 16; ++i) { o0[i] *= alpha; o1[i] *= alpha; }
        }
        const float m_eff = (OWN || lsel) ? m_run : INFINITY;
        float ps = 0.f;
#pragma unroll
        for (int i = 0; i < 16; ++i) { s0[i] = __builtin_amdgcn_exp2f(s0[i] - m_eff); s1[i] = __builtin_amdgcn_exp2f(s1[i] - m_eff); ps += s0[i] + s1[i]; }
        l_run += ps;
        h16x8 pf[2][2];
#pragma unroll
        for (int s2 = 0; s2 < 2; ++s2)
#pragma unroll
            for (int j = 0; j < 8; ++j) { pf[0][s2][j] = (h16)s0[8 * s2 + j]; pf[1][s2][j] = (h16)s1[8 * s2 + j]; }
#pragma unroll
        for (int sh = 0; sh < 2; ++sh)
#pragma unroll
            for (int s2 = 0; s2 < 2; ++s2) {
                const LAS h16* vp = Vt + (32 * sh + 16 * s2) * AT_VP;
                const h16x8 v0 = __builtin_shufflevector(vtr4(vp), vtr4(vp + 4 * AT_VP), 0, 1, 2, 3, 4, 5, 6, 7);
                const h16x8 v1 = __builtin_shufflevector(vtr4(vp + 32), vtr4(vp + 4 * AT_VP + 32), 0, 1, 2, 3, 4, 5, 6, 7);
                o0 = __builtin_amdgcn_mfma_f32_32x32x16_f16(v0, pf[sh][s2], o0, 0, 0, 0);
                o1 = __builtin_amdgcn_mfma_f32_32x32x16_f16(v1, pf[sh][s2], o1, 0, 0, 0); }
    }
}
__device__ __forceinline__ void attn_phase(unsigned char* ws, LAS unsigned char* lds, int tid, int lane, int w) {
    const h16* PROJ = (const h16*)(ws + OFF_PROJ); const float* KMEAN = (const float*)(ws + OFF_KMEAN);
    h16* YATT = (h16*)(ws + OFF_YATT);
    { const float* AGG = (const float*)(ws + OFF_AGG); float* CARRY = (float*)(ws + OFF_CARRY);
      for (int sc = blockIdx.x * 8 + w; sc < B_ * 256; sc += gridDim.x * 8) {
          const int b = sc >> 8, cj = sc & 255;
          const size_t o0 = ((size_t)b * 128 + 2 * lane) * 256 + cj, o1 = o0 + 256;
          const f32x2 g0 = *(const f32x2*)(AGG + o0 * 2), g1 = *(const f32x2*)(AGG + o1 * 2);
          float A = g0.x * g1.x, H = g1.x * g0.y + g1.y;
#pragma unroll
          for (int d = 1; d < 64; d <<= 1) { const float Ap = __shfl_up(A, d), Hp = __shfl_up(H, d); if (lane >= d) { H = A * Hp + H; A = A * Ap; } }
          float He = __shfl_up(H, 1); if (lane == 0) He = 0.f;
          CARRY[o0] = He; CARRY[o1] = g0.x * He + g0.y; } }
    const int r32 = lane & 31, hi = lane >> 5;
    LAS h16* Kb = (LAS h16*)lds; LAS h16* Vb = (LAS h16*)(lds + 2 * AT_KB * 2); LAS float* KM = (LAS float*)(lds + 2 * AT_KB * 2 + 2 * AT_VB * 2);
    const int srow = tid >> 3, sch = tid & 7;
    const int sig = (r32 & 19) | ((r32 & 4) << 1) | ((r32 & 8) >> 1);
    const int vbase = (8 * hi + ((lane & 15) >> 2)) * AT_VP + 16 * ((lane >> 4) & 1) + 4 * (lane & 3);
    for (int it = blockIdx.x; it < 1024; it += gridDim.x) {
        int own, bh;
        if (gridDim.x == 256) { const int rnd = it >> 8, xcd = it & 7, i5 = (it >> 3) & 31; bh = xcd * 8 + 2 * rnd + (i5 >> 4); own = (rnd & 1) ? (i5 & 15) : 15 - (i5 & 15); }
        else { const int rnd = it >> 8, c = it & 255, g = c >> 6; bh = c & 63; own = rnd == 0 ? 15 - g : rnd == 1 ? 8 + g : rnd == 2 ? 7 - g : g; }
        const int b = bh >> 3, h = bh & 7;
        __syncthreads();
        { const f32x2 kv = *(const f32x2*)(KMEAN + (size_t)bh * 1024 + 2 * tid); KM[2 * tid] = kv.x; KM[2 * tid + 1] = kv.y; }
        const size_t tokq = (size_t)b * S_ + own * 256 + 32 * w + r32;
        const h16* qrow = PROJ + tokq * NPROJ + C_Q + h * 64 + 8 * hi;
        h16x8 qf[4];
#pragma unroll
        for (int ks = 0; ks < 4; ++ks) qf[ks] = *(const h16x8*)(qrow + 16 * ks);
        const h16* kg = PROJ + ((size_t)b * S_ + srow) * NPROJ + C_K + h * 64 + sch * 8;
        const int T = 2 * (own + 1);
#define AT_TOK(ti) (((ti) < 2 ? own : (((ti) - 2) >> 1)) * 256 + ((ti) & 1) * 128)
#define AT_LOAD(R, ti) do { const h16* p_ = kg + (size_t)AT_TOK(ti) * NPROJ; R[0] = *(const u32x4*)p_; R[1] = *(const u32x4*)(p_ + (size_t)64 * NPROJ); \
        R[2] = *(const u32x4*)(p_ + (C_V - C_K)); R[3] = *(const u32x4*)(p_ + (size_t)64 * NPROJ + (C_V - C_K)); } while (0)
#define AT_STORE(R, buf) do { LAS h16* kd_ = Kb + (buf) * AT_KB + srow * AT_KP + sch * 8; LAS h16* vd_ = Vb + (buf) * AT_VB + srow * AT_VP + sch * 8; \
        *(LAS u32x4*)kd_ = R[0]; *(LAS u32x4*)(kd_ + 64 * AT_KP) = R[1]; *(LAS u32x4*)vd_ = R[2]; *(LAS u32x4*)(vd_ + 64 * AT_VP) = R[3]; } while (0)
        u32x4 R[4];
        AT_LOAD(R, 0);
        __syncthreads();
        unsigned sel = 0;
        {
            float b0 = -INFINITY, b1 = -INFINITY, b2 = -INFINITY; int i0 = -1, i1 = -1, i2 = -1;
#pragma unroll 1
            for (int n = 0; n < own; ++n) {
                float sc = 0.f;
#pragma unroll
                for (int ks = 0; ks < 4; ++ks)
#pragma unroll
                    for (int jj = 0; jj < 2; ++jj) { const f32x4 kmv = *(const LAS f32x4*)(KM + n * 64 + 16 * ks + 8 * hi + 4 * jj);
                        sc += (float)qf[ks][4 * jj + 0] * kmv.x + (float)qf[ks][4 * jj + 1] * kmv.y + (float)qf[ks][4 * jj + 2] * kmv.z + (float)qf[ks][4 * jj + 3] * kmv.w; }
                sc += __shfl_xor(sc, 32);
                const bool g0 = sc > b0, g1 = sc > b1, g2 = sc > b2;
                b2 = g1 ? b1 : (g2 ? sc : b2); i2 = g1 ? i1 : (g2 ? n : i2);
                b1 = g0 ? b0 : (g1 ? sc : b1); i1 = g0 ? i0 : (g1 ? n : i1);
                b0 = g0 ? sc : b0;             i0 = g0 ? n : i0;
            }
            if (i0 >= 0) sel |= 1u << i0;
            if (i1 >= 0) sel |= 1u << i1;
            if (i2 >= 0) sel |= 1u << i2;
        }
        AT_STORE(R, 0);
        AT_LOAD(R, 1);
        __syncthreads();
        float m_run = -INFINITY, l_run = 0.f;
        f32x16 o0, o1;
#pragma unroll
        for (int i = 0; i < 16; ++i) { o0[i] = 0.f; o1[i] = 0.f; }
        for (int ti = 0; ti < T; ++ti) {
            const int buf = ti & 1;
            AT_STORE(R, buf ^ 1);
            { const int tn = (ti + 2 < T) ? ti + 2 : T - 1; AT_LOAD(R, tn); }
            const int blk = ti < 2 ? own : (ti - 2) >> 1; const bool isown = (blk == own), lsel = isown || ((sel >> blk) & 1u);
            if (isown) attn_tile<true>(Kb + buf * AT_KB, Vb + buf * AT_VB, qf, o0, o1, m_run, l_run, true, ti & 1, w, r32, hi, sig, vbase);
            else if (__ballot(lsel) != 0ull) attn_tile<false>(Kb + buf * AT_KB, Vb + buf * AT_VB, qf, o0, o1, m_run, l_run, lsel, ti & 1, w, r32, hi, sig, vbase);
            WG_BAR();
        }
#undef AT_TOK
#undef AT_LOAD
#undef AT_STORE
        l_run += __shfl_xor(l_run, 32);
        const float inv = 1.0f / l_run;
        h16* orow = YATT + tokq * 512 + h * 64 + 4 * hi;
#pragma unroll
        for (int q = 0; q < 4; ++q) {
            u32x2 w0; w0.x = pkh(o0[4 * q] * inv, o0[4 * q + 1] * inv); w0.y = pkh(o0[4 * q + 2] * inv, o0[4 * q + 3] * inv);
            u32x2 w1; w1.x = pkh(o1[4 * q] * inv, o1[4 * q + 1] * inv); w1.y = pkh(o1[4 * q + 2] * inv, o1[4 * q + 3] * inv);
            *(u32x2*)(orow + 8 * q) = w0; *(u32x2*)(orow + 32 + 8 * q) = w1; }
    }
}

__device__ __forceinline__ float gelu_tanh(float x) { const float z = 0.7978845608028654f * (x + 0.044715f * x * x * x); const float t = 1.0f - 2.0f / (__expf(2.0f * z) + 1.0f); return 0.5f * x * (1.0f + t); }
__device__ __forceinline__ void mixnorm_phase(unsigned char* ws, int l, int gw, int NGW, int lane) {
    const float* PB = (const float*)(ws + OFF_PB) + (size_t)l * PB_LAYER;
    const h16* PROJ = (const h16*)(ws + OFF_PROJ); const h16* YATT = (const h16*)(ws + OFF_YATT);
    const h16* HLOC = (const h16*)(ws + OFF_HLOC); const h16* PCUM = (const h16*)(ws + OFF_PCUM); const float* CARRY = (const float*)(ws + OFF_CARRY);
    h16* Y = (h16*)(ws + OFF_Y);
    const float* mg = PB + PB_MIXG; const float* scw = PB + PB_SCW;
    for (int tok0 = gw * 2; tok0 < M_; tok0 += NGW * 2) {
        float fa[2][8], yc[2][4], yl[2][4], ssa[2], ssc[2], ssl[2];
#pragma unroll
        for (int u = 0; u < 2; ++u) {
            const int tok = tok0 + u; const int b = tok >> 12, t = tok & 4095, chn = t >> 5;
            const h16x8 ya = *(const h16x8*)(YATT + (size_t)tok * 512 + 8 * lane);
            float sa_ = 0.f;
#pragma unroll
            for (int j = 0; j < 8; ++j) { fa[u][j] = (float)ya[j]; sa_ += fa[u][j] * fa[u][j]; }
            ssa[u] = sa_;
            const h16* pr = PROJ + (size_t)tok * NPROJ;
            const h16x4 bb = *(const h16x4*)(pr + C_SCB + 4 * lane);
            f32x4 conv = {0.f, 0.f, 0.f, 0.f};
#pragma unroll
            for (int k = 0; k < 3; ++k) { if (t - 2 + k >= 0) { const h16* pk = pr + (k - 2) * NPROJ;
                const h16x4 cc = *(const h16x4*)(pk + C_SCC + 4 * lane), uu = *(const h16x4*)(pk + C_SCU + 4 * lane);
                const f32x4 wv = *(const f32x4*)(scw + k * 256 + 4 * lane);
#pragma unroll
                for (int j = 0; j < 4; ++j) conv[j] += wv[j] * ((float)cc[j] * (float)uu[j]); } }
            float sc_ = 0.f;
#pragma unroll
            for (int j = 0; j < 4; ++j) { yc[u][j] = (float)bb[j] * conv[j]; sc_ += yc[u][j] * yc[u][j]; }
            ssc[u] = sc_;
            const h16x4 hl = *(const h16x4*)(HLOC + (size_t)tok * 256 + 4 * lane), pc = *(const h16x4*)(PCUM + (size_t)tok * 256 + 4 * lane);
            const f32x4 cr = *(const f32x4*)(CARRY + ((size_t)b * 128 + chn) * 256 + 4 * lane);
            const h16x4 lg = *(const h16x4*)(pr + C_LG + 4 * lane);
            float sl_ = 0.f;
#pragma unroll
            for (int j = 0; j < 4; ++j) { const float hv = (float)hl[j] + (float)pc[j] * cr[j]; yl[u][j] = hv * gelu_tanh((float)lg[j]); sl_ += yl[u][j] * yl[u][j]; }
            ssl[u] = sl_;
        }
#pragma unroll
        for (int o = 1; o < 64; o <<= 1) {
#pragma unroll
            for (int u = 0; u < 2; ++u) { ssa[u] += __shfl_xor(ssa[u], o); ssc[u] += __shfl_xor(ssc[u], o); ssl[u] += __shfl_xor(ssl[u], o); } }
        const f32x4 ga0 = *(const f32x4*)(mg + 8 * lane), ga1 = *(const f32x4*)(mg + 8 * lane + 4), gc = *(const f32x4*)(mg + 512 + 4 * lane), gl = *(const f32x4*)(mg + 768 + 4 * lane);
#pragma unroll
        for (int u = 0; u < 2; ++u) {
            const float ra = rsqrtf(ssa[u] * (1.0f / 512.0f) + EPS_), rc = rsqrtf(ssc[u] * (1.0f / 256.0f) + EPS_), rl = rsqrtf(ssl[u] * (1.0f / 256.0f) + EPS_);
            h16* yo = Y + (size_t)(tok0 + u) * 1024;
            { u32x4 o; o.x = pkh(fa[u][0] * ra * ga0.x, fa[u][1] * ra * ga0.y); o.y = pkh(fa[u][2] * ra * ga0.z, fa[u][3] * ra * ga0.w);
              o.z = pkh(fa[u][4] * ra * ga1.x, fa[u][5] * ra * ga1.y); o.w = pkh(fa[u][6] * ra * ga1.z, fa[u][7] * ra * ga1.w);
              *(u32x4*)(yo + 8 * lane) = o; }
            { u32x2 o; o.x = pkh(yc[u][0] * rc * gc.x, yc[u][1] * rc * gc.y); o.y = pkh(yc[u][2] * rc * gc.z, yc[u][3] * rc * gc.w);
              *(u32x2*)(yo + 512 + 4 * lane) = o; }
            { u32x2 o; o.x = pkh(yl[u][0] * rl * gl.x, yl[u][1] * rl * gl.y); o.y = pkh(yl[u][2] * rl * gl.z, yl[u][3] * rl * gl.w);
              *(u32x2*)(yo + 768 + 4 * lane) = o; }
        }
    }
}

#define XB_TMO      128
#define XB_XCNT(j)  (256  + 64 * (j))
#define XB_XSUB(j)  (1280 + 64 * (j))
#define XB_XGEN(j)  (2304 + 64 * (j))
#define XB_TOP      3328
#define XB_TOPGEN   3392
#define XCD_BAR_WORDS 3456
#define XB_SPIN_CAP (1u << 18)

__device__ __forceinline__ unsigned xb_ld(unsigned* p)              { return __hip_atomic_load(p, __ATOMIC_RELAXED, __HIP_MEMORY_SCOPE_AGENT); }
__device__ __forceinline__ unsigned xb_add(unsigned* p, unsigned v) { return __hip_atomic_fetch_add(p, v, __ATOMIC_RELAXED, __HIP_MEMORY_SCOPE_AGENT); }
__device__ __forceinline__ unsigned xb_xcc_id() { return (unsigned)__builtin_amdgcn_s_getreg((3 << 11) | 20) & 0xFu; }
#define XB_SPIN(cond, bar) do { unsigned _sp = 0; while (cond) { __builtin_amdgcn_s_sleep(1); \
    if ((++_sp & 255u) == 0u) { if (xb_ld(&(bar)[XB_TMO])) break; if (_sp > XB_SPIN_CAP) { atomicAdd(&(bar)[XB_TMO], 1u); break; } } } } while (0)

struct XcdBarrier {
    unsigned* bar; unsigned x;
    volatile LAS unsigned* st;
};

__device__ __forceinline__ XcdBarrier xcd_barrier_post(unsigned* bar, volatile LAS unsigned* st) {
    XcdBarrier b; b.bar = bar; b.x = xb_xcc_id(); b.st = st;
    if (threadIdx.x == 0) (void)xb_add(&bar[XB_XCNT(b.x)], 1u);
    return b;
}
__device__ __forceinline__ void xcd_barrier_complete(unsigned* bar, unsigned x, unsigned& nloc, unsigned& nx) {
    const unsigned G = gridDim.x * gridDim.y * gridDim.z;
    unsigned sum, cnt, mine, sp = 0u;
    for (;;) {
        sum = 0u; cnt = 0u; mine = 0u;
#pragma unroll
        for (unsigned j = 0; j < 16; ++j) { const unsigned c = xb_ld(&bar[XB_XCNT(j)]); sum += c; cnt += (c > 0u) ? 1u : 0u; mine = (j == x) ? c : mine; }
        if (sum == G) break;
        __builtin_amdgcn_s_sleep(1);
        if ((++sp & 255u) == 0u) { if (xb_ld(&bar[XB_TMO])) break; if (sp > XB_SPIN_CAP) { atomicAdd(&bar[XB_TMO], 1u); break; } }
    }
    nloc = mine > 0u ? mine : 1u; nx = cnt > 0u ? cnt : 1u;
}

__device__ __forceinline__ void xcd_barrier(const XcdBarrier& b) {
    asm volatile("s_waitcnt vmcnt(0)" ::: "memory");
    __syncthreads();
    if (threadIdx.x == 0) {
        unsigned* bar = b.bar;
        __builtin_amdgcn_s_waitcnt(0);
        unsigned nloc = b.st[0], nx = b.st[1];
        if (nloc == 0u) { xcd_barrier_complete(bar, b.x, nloc, nx); b.st[0] = nloc; b.st[1] = nx; }
        const unsigned old = xb_add(&bar[XB_XSUB(b.x)], 1u);
        const unsigned gen = old / nloc;
        if (old + 1u == (gen + 1u) * nloc) {
            __builtin_amdgcn_fence(__ATOMIC_RELEASE, "agent");
            asm volatile("s_waitcnt vmcnt(0)" ::: "memory");
            const unsigned og = xb_add(&bar[XB_TOP], 1u);
            const unsigned tg = og / nx;
            if (og + 1u == (tg + 1u) * nx) xb_add(&bar[XB_TOPGEN], 1u);
            else XB_SPIN(xb_ld(&bar[XB_TOPGEN]) == tg, bar);
            __builtin_amdgcn_fence(__ATOMIC_ACQUIRE, "agent");
            xb_add(&bar[XB_XGEN(b.x)], 1u);
            asm volatile("s_waitcnt vmcnt(0)" ::: "memory");
        } else {
            XB_SPIN(xb_ld(&bar[XB_XGEN(b.x)]) == gen, bar);
            __builtin_amdgcn_fence(__ATOMIC_ACQUIRE, "agent");
            asm volatile("s_waitcnt vmcnt(0)" ::: "memory");
        }
    }
    __syncthreads();
}

struct EpiAny {
    static constexpr bool PERM = true, AFTER_DRAIN = false;
    unsigned char* ws; const float* xptr; float* optr; int l, k;
    __device__ __forceinline__ void operator()(const pg8::f32x4 (&acc)[2][2][4][2], const pg8::Unit& u, int wr, int wc, int fr, int fq) const {
        const float* PBl = (const float*)(ws + OFF_PB) + (size_t)l * PB_LAYER; const float* modl = (const float*)(ws + OFF_MOD) + (size_t)l * 8 * 6144;
        if (k == 1) { const pg8::EpiInProj E{(pg8::bf16_t*)(ws + OFF_PROJ), PBl + PB_QG, PBl + PB_KG, (float*)(ws + OFF_KMEAN), QSCALE}; E(acc, u, wr, wc, fr, fq); }
        else if (k == 7) { const pg8::EpiH16<1> E{(pg8::bf16_t*)(ws + OFF_HID), FF_}; E(acc, u, wr, wc, fr, fq); }
        else { const bool dn = (k == 8), last = dn && (l == NL_ - 1), first = !dn && (l == 0); h16* XA = (h16*)(ws + OFF_XA);
            const pg8::EpiRes16 E{first ? (const void*)xptr : (const void*)XA, last ? (void*)optr : (void*)XA, D_, modl + (dn ? 5 : 2) * 1024, 6144, first ? 1 : 0, last ? 1 : 0}; E(acc, u, wr, wc, fr, fq); }
    }
};

#define OPQ_S(x) asm volatile("" : "+s"(x))
#define OPQ_V(x) asm volatile("" : "+v"(x))
__global__ void __launch_bounds__(512, 2) fwd_kernel(Args a) {
    extern __shared__ __attribute__((aligned(16))) unsigned char lds_raw[];
    cg::grid_group grid = cg::this_grid();
    LAS unsigned char* lds = (LAS unsigned char*)lds_raw;
    volatile LAS unsigned* barst = (volatile LAS unsigned*)(lds + LDS_BARST);
    if (threadIdx.x < 2) barst[threadIdx.x] = 0u;
    __syncthreads();
    XcdBarrier xbar = xcd_barrier_post((unsigned*)(a.ws + OFF_BAR), barst);
    { const int tid = threadIdx.x, lane = tid & 63, wave = __builtin_amdgcn_readfirstlane(tid >> 6);
      p0_phase(a, lds, tid, lane, wave); }
    grid.sync();
    const float* xptr = a.in[I_X]; float* optr = a.out; unsigned char* wsb = a.ws;
#pragma unroll 1
    for (int step = 0; step < 9 * NL_; ++step) {
        const int l = step / 9, k = step - 9 * l;
#define PH_BEGIN GAS unsigned char* wsg_ = (GAS unsigned char*)wsb; OPQ_S(wsg_); unsigned char* ws = (unsigned char*)wsg_;     int tid = threadIdx.x; OPQ_V(tid); const int lane = tid & 63, wave = __builtin_amdgcn_readfirstlane(tid >> 6); \
        const int G = gridDim.x, gw = blockIdx.x * 8 + wave, NGW = G * 8; (void)gw; (void)NGW; (void)lane; \
        const float* modl = (const float*)(ws + OFF_MOD) + (size_t)l * 8 * 6144; const unsigned char* wl = ws + OFF_W + (size_t)l * W_LAYER; (void)modl; (void)wl; \
        h16* H = (h16*)(ws + OFF_H); h16* XA = (h16*)(ws + OFF_XA); (void)H; (void)XA;
        { PH_BEGIN
          const float* PBl = (const float*)(ws + OFF_PB) + (size_t)l * PB_LAYER;
          if (k == 0 || k == 6) {
              const float* gp = PBl + (k == 0 ? PB_LN1G : PB_LN2G); const int shc = (k == 0) ? 0 : 3, scc = (k == 0) ? 1 : 4;
              ln_phase(step != 0, step == 0 ? (const void*)xptr : (const void*)XA, gp, modl, shc, scc, H, gw, NGW, lane);
          } else if (k == 2) { lru_phase(ws, l, lds, lane, wave);
          } else if (k == 3) { attn_phase(ws, lds, tid, lane, wave);
          } else if (k == 4) { mixnorm_phase(ws, l, gw, NGW, lane);
          } else {
              const unsigned char* Ap = ws + (k == 5 ? OFF_Y : k == 8 ? OFF_HID : OFF_H);
              const unsigned char* Bp = wl + (k == 1 ? W_IN : k == 5 ? W_OUT : k == 7 ? W_UP : W_DOWN);
              const int Ng = (k == 1) ? NPROJ : (k == 7) ? FF_ : D_, Kg = (k == 8) ? FF_ : D_;
              pg8::Gemm g{(const pg8::bf16_t*)Ap, (const pg8::bf16_t*)Bp, M_, Ng, Kg}; pg8::StaticOrder S; S.init(M_, Ng, G, (int)blockIdx.x);
              EpiAny E{ws, xptr, optr, l, k};
              pg8::gemm_phase<EpiAny, pg8::StaticOrder, true, true>(lds, g, S, E);
          }
        }
        if (step + 1 < 9 * NL_) xcd_barrier(xbar);
    }
}

extern "C" void kernel_launch(void* const* d_in, const int* in_sizes, int n_in, void* d_out, int out_size, void* d_ws, size_t ws_size, hipStream_t stream) {
    static int grid = 0;
    if (grid == 0) {
        if (n_in != 21 || out_size != M_ * D_ || ws_size < WS_END) { fprintf(stderr, "kernel_launch: unexpected shapes (n_in %d out %d ws %zu)\n", n_in, out_size, ws_size); grid = -1; return; }
        int dev = 0, cus = 0, per_cu = 0;
        (void)hipGetDevice(&dev);
        (void)hipDeviceGetAttribute(&cus, hipDeviceAttributeMultiprocessorCount, dev);
        (void)hipFuncSetAttribute((const void*)fwd_kernel, hipFuncAttributeMaxDynamicSharedMemorySize, LDS_BYTES);
        if (hipOccupancyMaxActiveBlocksPerMultiprocessor(&per_cu, (const void*)fwd_kernel, 512, LDS_BYTES) != hipSuccess || per_cu < 1) per_cu = 1;
        (void)hipGetLastError();
        grid = cus * per_cu;
    }
    if (grid < 0) return;
    Args a{};
    for (int i = 0; i < 21; ++i) a.in[i] = (const float*)d_in[i];
    a.out = (float*)d_out; a.ws = (unsigned char*)d_ws;
    (void)hipMemsetAsync((unsigned char*)d_ws + OFF_BAR, 0, BAR_BYTES, stream);
    void* args[] = {&a};
    hipError_t e = hipLaunchCooperativeKernel((const void*)fwd_kernel, dim3(grid), dim3(512), args, LDS_BYTES, stream);
    if (e != hipSuccess) fprintf(stderr, "cooperative launch failed: %s (grid %d)\n", hipGetErrorString(e), grid);
}
```
